# Optimizing an MI355X kernel written in HIP

```python
import jax, jax.numpy as jnp
from jax import lax
import numpy as np

D_MODEL = 1024
BATCH = 8
SEQ = 4096
DEPTH = 4

N_MIXERS = 2
N_CONV_LAYERS = (DEPTH + N_MIXERS - 1) // N_MIXERS
N_ATTN_LAYERS = DEPTH // N_MIXERS
NORM_EPS = 1e-6
CONV_WIDTH = 3
HEAD_DIM = 64
HEADS_PER_GROUP = D_MODEL // HEAD_DIM
DILATED_GROUPS = ((128, 1), (512, 4), (2048, 16))
N_ATTN_GROUPS = len(DILATED_GROUPS)
QKV_WIDTH = N_ATTN_GROUPS * 3 * HEADS_PER_GROUP * HEAD_DIM
ROPE_THETA = 10000.0
N_EXPERT_GROUPS = 4
EXPERTS_PER_GROUP = 4
N_EXPERTS = N_EXPERT_GROUPS * EXPERTS_PER_GROUP
FINE_TOP_K = 2
EXPERT_FF = D_MODEL // 2

kernel_name = "hybrid_shortconv_dilated_attn_hmoe"


def rms_norm(x, g):
    xf = x.astype(jnp.float32)
    y = xf * lax.rsqrt(jnp.mean(xf * xf, axis=-1, keepdims=True) + NORM_EPS)
    return (y * g.astype(jnp.float32)).astype(x.dtype)


def rope_tables(positions):
    inv_freq = ROPE_THETA ** (-jnp.arange(0, HEAD_DIM, 2, dtype=jnp.float32) / HEAD_DIM)
    ang = positions.astype(jnp.float32)[..., None] * inv_freq
    return jnp.cos(ang)[:, :, None, :], jnp.sin(ang)[:, :, None, :]


def apply_rope(t, cos, sin):
    tf = t.astype(jnp.float32)
    t1, t2 = jnp.split(tf, 2, axis=-1)
    return jnp.concatenate([t1 * cos - t2 * sin, t2 * cos + t1 * sin], axis=-1).astype(t.dtype)


def short_conv_mixer(x, w_in, conv_w, w_out):
    gate_b, gate_c, h = jnp.split(x @ w_in, 3, axis=-1)
    u = gate_c * h
    conv = lax.conv_general_dilated(
        u, conv_w.reshape(CONV_WIDTH, 1, D_MODEL).astype(u.dtype),
        window_strides=(1,), padding=[(CONV_WIDTH - 1, 0)],
        dimension_numbers=("NWC", "WIO", "NWC"), feature_group_count=D_MODEL)
    return (gate_b * conv) @ w_out


def dilated_window_attention(q, k, v, dilation, n_back):
    B, S, H, Dh = q.shape
    L = S // dilation
    blk = n_back
    nb = -(-L // blk)
    Lp = nb * blk

    def to_strided(t):
        t = t.reshape(B, L, dilation, H, Dh)
        t = jnp.pad(t, ((0, 0), (0, Lp - L), (0, 0), (0, 0), (0, 0)))
        return t.reshape(B, nb, blk, dilation, H, Dh)

    def with_prev(t):
        prev = jnp.pad(t, ((0, 0), (1, 0), (0, 0), (0, 0), (0, 0), (0, 0)))[:, :-1]
        return jnp.concatenate([prev, t], axis=2)

    qs = to_strided(q)
    kb = with_prev(to_strided(k))
    vb = with_prev(to_strided(v))
    scores = jnp.einsum("bnqrhd,bnkrhd->bnrhqk", qs, kb,
                        preferred_element_type=jnp.float32) * (Dh ** -0.5)
    qi = jnp.arange(blk)[:, None]
    ki = jnp.arange(2 * blk)[None, :]
    dist = qi + blk - ki
    band = (dist >= 0) & (dist <= n_back)
    key_valid = (jnp.arange(nb)[:, None] * blk - blk + ki) >= 0
    mask = band[None] & key_valid[:, None, :]
    scores = jnp.where(mask[None, :, None, None], scores, -jnp.inf)
    m = jnp.max(scores, axis=-1, keepdims=True)
    p = jnp.exp(scores - m)
    denom = jnp.sum(p, axis=-1)
    o = jnp.einsum("bnrhqk,bnkrhd->bnqrhd", p, vb.astype(jnp.float32))
    o = o / jnp.transpose(denom, (0, 1, 4, 2, 3))[..., None]
    lse = jnp.transpose(m[..., 0] + jnp.log(denom), (0, 1, 4, 2, 3))
    o = o.reshape(B, Lp, dilation, H, Dh)[:, :L].reshape(B, S, H, Dh)
    lse = lse.reshape(B, Lp, dilation, H)[:, :L].reshape(B, S, H)
    return o, lse


def dilated_attention_mixer(x, w_qkv, w_o, cos, sin):
    B, S, _ = x.shape
    qkv = (x @ w_qkv).reshape(B, S, N_ATTN_GROUPS, 3, HEADS_PER_GROUP, HEAD_DIM)
    outs, lses = [], []
    for g, (window, dilation) in enumerate(DILATED_GROUPS):
        q = apply_rope(qkv[:, :, g, 0], cos, sin)
        k = apply_rope(qkv[:, :, g, 1], cos, sin)
        o, lse = dilated_window_attention(q, k, qkv[:, :, g, 2], dilation, window // dilation)
        outs.append(o)
        lses.append(lse)
    o_all = jnp.stack(outs, axis=3)
    w_grp = jax.nn.softmax(jnp.stack(lses, axis=-1), axis=-1)
    merged = jnp.einsum("bshg,bshgd->bshd", w_grp, o_all).reshape(B, S, D_MODEL)
    return merged.astype(x.dtype) @ w_o


def hierarchical_moe(x, w_coarse, b_coarse, w_fine, b_fine, w_gate, w_up, w_down):
    B, S, D = x.shape
    t = x.reshape(-1, D)
    coarse_logits = (t @ w_coarse).astype(jnp.float32) + b_coarse.astype(jnp.float32)
    coarse_prob = jax.nn.softmax(coarse_logits, axis=-1)
    p_top, g_top = lax.top_k(coarse_prob, 1)
    fine_all = jnp.einsum("nd,gde->nge", t, w_fine).astype(jnp.float32) + b_fine.astype(jnp.float32)
    fine_logits = jnp.take_along_axis(fine_all, g_top[:, :, None], axis=1)[:, 0]
    f_val, f_idx = lax.top_k(fine_logits, FINE_TOP_K)
    gate = p_top * jax.nn.softmax(f_val, axis=-1)
    expert_idx = g_top * EXPERTS_PER_GROUP + f_idx
    combine = jnp.sum(jax.nn.one_hot(expert_idx, N_EXPERTS, dtype=jnp.float32) * gate[..., None], axis=1)
    out = jnp.zeros(t.shape, jnp.float32)
    for e in range(N_EXPERTS):
        h = jax.nn.silu(t @ w_gate[e]) * (t @ w_up[e])
        out = out + combine[:, e:e + 1] * (h @ w_down[e])
    return out.reshape(B, S, D).astype(x.dtype)


def setup_inputs(seed: int = 0) -> dict:
    key = jax.random.key(seed)
    ks = jax.random.split(key, 20)
    f32 = jnp.float32
    nrm = lambda k, shape, s: jax.random.normal(k, shape, f32) * s
    d_s = D_MODEL ** -0.5
    return {
        "x": nrm(ks[0], (BATCH, SEQ, D_MODEL), 1.0),
        "positions": jnp.broadcast_to(jnp.arange(SEQ, dtype=jnp.int32), (BATCH, SEQ)),
        "norm_mix": 1.0 + nrm(ks[1], (DEPTH, D_MODEL), 0.05),
        "norm_ffn": 1.0 + nrm(ks[2], (DEPTH, D_MODEL), 0.05),
        "norm_final": 1.0 + nrm(ks[3], (D_MODEL,), 0.05),
        "conv_w_in": nrm(ks[4], (N_CONV_LAYERS, D_MODEL, 3 * D_MODEL), d_s),
        "conv_w": nrm(ks[5], (N_CONV_LAYERS, CONV_WIDTH, D_MODEL), CONV_WIDTH ** -0.5),
        "conv_w_out": nrm(ks[6], (N_CONV_LAYERS, D_MODEL, D_MODEL), d_s),
        "attn_w_qkv": nrm(ks[7], (N_ATTN_LAYERS, D_MODEL, QKV_WIDTH), d_s),
        "attn_w_o": nrm(ks[8], (N_ATTN_LAYERS, D_MODEL, D_MODEL), d_s),
        "w_coarse": nrm(ks[9], (DEPTH, D_MODEL, N_EXPERT_GROUPS), d_s),
        "b_coarse": nrm(ks[10], (DEPTH, N_EXPERT_GROUPS), 0.01),
        "w_fine": nrm(ks[11], (DEPTH, N_EXPERT_GROUPS, D_MODEL, EXPERTS_PER_GROUP), d_s),
        "b_fine": nrm(ks[12], (DEPTH, N_EXPERT_GROUPS, EXPERTS_PER_GROUP), 0.01),
        "w_gate": nrm(ks[13], (DEPTH, N_EXPERTS, D_MODEL, EXPERT_FF), d_s),
        "w_up": nrm(ks[14], (DEPTH, N_EXPERTS, D_MODEL, EXPERT_FF), d_s),
        "w_down": nrm(ks[15], (DEPTH, N_EXPERTS, EXPERT_FF, D_MODEL), EXPERT_FF ** -0.5),
    }


def reference(x, positions, norm_mix, norm_ffn, norm_final, conv_w_in, conv_w, conv_w_out,
              attn_w_qkv, attn_w_o, w_coarse, b_coarse, w_fine, b_fine, w_gate, w_up, w_down):
    cos, sin = rope_tables(positions)
    h = x
    for i in range(DEPTH):
        hn = rms_norm(h, norm_mix[i])
        j = i // N_MIXERS
        if i % N_MIXERS == 0:
            h = h + short_conv_mixer(hn, conv_w_in[j], conv_w[j], conv_w_out[j])
        else:
            h = h + dilated_attention_mixer(hn, attn_w_qkv[j], attn_w_o[j], cos, sin)
        hn = rms_norm(h, norm_ffn[i])
        h = h + hierarchical_moe(hn, w_coarse[i], b_coarse[i], w_fine[i], b_fine[i],
                                 w_gate[i], w_up[i], w_down[i])
    return rms_norm(h, norm_final)
```

```cpp
#include <hip/hip_runtime.h>
#include <hip/hip_fp16.h>
#include <cstdio>
#include <cstdint>

#define LAS __attribute__((address_space(3)))
#define GAS __attribute__((address_space(1)))
typedef unsigned short bf16_t;
typedef short bf16x8 __attribute__((ext_vector_type(8)));
typedef short s16x4 __attribute__((ext_vector_type(4)));
typedef float f32x2 __attribute__((ext_vector_type(2)));
typedef float f32x4 __attribute__((ext_vector_type(4)));
typedef float f32x16 __attribute__((ext_vector_type(16)));
typedef unsigned u32x2 __attribute__((ext_vector_type(2)));
typedef unsigned u32x4 __attribute__((ext_vector_type(4)));
typedef __bf16 bf16x2_t __attribute__((ext_vector_type(2)));
typedef _Float16 h16x8 __attribute__((ext_vector_type(8)));

#ifndef MK_N_LAUNCHES
#define MK_N_LAUNCHES 1
#endif

constexpr int NTOK = 32768, DM = 1024, SEQ = 4096, DEPTH = 4;
constexpr int HTOK = 16384;
constexpr int QKVW = 9216;
constexpr float EPS = 1e-6f;
constexpr float LOG2E = 1.4426950408889634f;
constexpr float C2 = 0.125f * LOG2E;
constexpr int NPHASE = 33;

constexpr size_t MiB = 1u << 20;
constexpr size_t WS_CTL = 0, CTL_ZERO_BYTES = 1 * MiB;
constexpr size_t WS_LIST = 1 * MiB;
constexpr size_t WS_GATE = 3 * MiB;
constexpr size_t WS_COS = 5 * MiB;
constexpr size_t WS_SIN = 7 * MiB;
constexpr size_t WS_WCIN = 9 * MiB;
constexpr size_t WS_WCOUT = 21 * MiB;
constexpr size_t WS_WQKV = 25 * MiB;
constexpr size_t WS_WO = 61 * MiB;
constexpr size_t WS_WGU = 65 * MiB;
constexpr size_t WS_WDN = 193 * MiB;
constexpr size_t WS_HN = 257 * MiB;
constexpr size_t WS_R = 321 * MiB;
constexpr size_t WS_END = 609 * MiB;
constexpr size_t R_BG = 0, R_U = 64 * MiB, R_Y = 128 * MiB;
constexpr size_t R_H = 0, R_YS = 72 * MiB;
constexpr int CW_CNT = 1024;
constexpr int CW_BAR = 4096;

constexpr int RING_BYTES = 139264;
constexpr int LDSCTL_OFF = RING_BYTES, MISC_OFF = LDSCTL_OFF + 1024;
constexpr int LDS_BYTES = 147456;

__device__ __forceinline__ unsigned cvtpk(float lo, float hi) { f32x2 v = {lo, hi}; bf16x2_t b = __builtin_convertvector(v, bf16x2_t); return __builtin_bit_cast(unsigned, b); }
__device__ __forceinline__ float bflo(unsigned u) { return __uint_as_float(u << 16); }
__device__ __forceinline__ float bfhi(unsigned u) { return __uint_as_float(u & 0xffff0000u); }
__device__ __forceinline__ float wave_sum(float v) {
#pragma unroll
    for (int o = 1; o < 64; o <<= 1) v += __shfl_xor(v, o);
    return v;
}
#define LDS_WAIT() asm volatile("s_waitcnt lgkmcnt(0)" ::: "memory")
#define VM_WAIT() asm volatile("s_waitcnt vmcnt(0)" ::: "memory")

namespace pg8 {
constexpr int BM = 256, BK = 64, HALF = 128, HTB = HALF * BK * 2, STAGE_BYTES = 8 * HTB, NXCD = 8, WGM = 8;
__host__ __device__ __forceinline__ int lds_byte(int r, int c) { const int st = (r >> 4) * 2 + (c >> 5), rr = r & 15, cc = c & 31, ob = rr * 64 + cc * 2; return st * 1024 + (ob ^ (((ob >> 9) & 1) << 5)); }
__host__ __device__ __forceinline__ void stage_rc(int b, int& R, int& C) { const int st = b / 1024, sb = b % 1024, swz = sb ^ (((sb >> 9) & 1) << 5); R = (st >> 1) * 16 + swz / 64; C = (st & 1) * 32 + (swz % 64) / 2; }
__host__ __device__ __forceinline__ int perm32(int rho) { const int n = rho >> 4, i = rho & 15; return 8 * (i >> 2) + 4 * n + (i & 3); }

struct Unit { int pm, pn, arow, brow, x0, x1; };
struct Gemm { const bf16_t* A; const bf16_t* Bt; int K; };

struct DenseOrder {
    int nM, nN, nwg, G, c;
    __device__ void init(int M, int N, int G_, int c_) { nM = M / BM; nN = N / BM; nwg = nM * nN; G = G_; c = c_; }
    __device__ bool next(int i, Unit& u) const {
        const long L = (long)i * G + c; if (L >= nwg) return false;
        int wgid = (int)L; { const int q = nwg / NXCD, r = nwg % NXCD, xcd = wgid % NXCD, off = wgid / NXCD; wgid = (xcd < r ? xcd * (q + 1) : r * (q + 1) + (xcd - r) * q) + off; }
        const int nig = WGM * nN, gid = wgid / nig, fm = gid * WGM, gsz = (nM - fm) < WGM ? (nM - fm) : WGM;
        u.pm = fm + ((wgid % nig) % gsz); u.pn = (wgid % nig) / gsz; u.arow = u.pm * BM; u.brow = u.pn * BM; u.x0 = 0; u.x1 = 0; return true;
    }
    __device__ __forceinline__ unsigned arow_of(const Unit&, int) const { return 0u; }
};
struct MoeOrder {
    const LAS int* tbl; int G, c; const int* list; int gather;
    __device__ bool next(int i, Unit& u) const {
        const int L = i * G + c; const int total = __builtin_amdgcn_readfirstlane(tbl[16]); if (L >= total) return false;
        int wgid = L; { const int q = total / NXCD, r = total % NXCD, xcd = wgid % NXCD, off = wgid / NXCD; wgid = (xcd < r ? xcd * (q + 1) : r * (q + 1) + (xcd - r) * q) + off; }
        int e = 0;
#pragma unroll
        for (int k = 1; k < 16; ++k) { const int s = __builtin_amdgcn_readfirstlane(tbl[k]); if (wgid >= s) e = k; }
        const int Le = wgid - __builtin_amdgcn_readfirstlane(tbl[e]);
        u.pm = Le >> 2; u.pn = Le & 3; u.x0 = e; u.x1 = __builtin_amdgcn_readfirstlane(tbl[64 + e]);
        u.arow = __builtin_amdgcn_readfirstlane(tbl[32 + e]) + u.pm * BM; u.brow = e * 1024 + u.pn * BM; return true;
    }
    __device__ __forceinline__ unsigned arow_of(const Unit& u, int r) const { const int pos = u.pm * BM + r; return pos < u.x1 ? (unsigned)(list[u.x0 * 32768 + pos] >> 1) : 0u; }
};

struct EpiConvIn {
    static constexpr bool PERM = true;
    bf16_t* Bg; bf16_t* U;
    __device__ __forceinline__ void operator()(const f32x4 (&acc)[2][2][4][2], const Unit& u, int wr, int wc, int fr, int fq) const {
        const int row0 = u.pm * BM + wr * 64 + fr;
        if (u.pn < 4) {
            const int col0 = u.pn * BM + wc * 32 + 8 * fq;
#pragma unroll
            for (int ai = 0; ai < 2; ++ai)
#pragma unroll
                for (int m = 0; m < 4; ++m) { bf16_t* rowp = Bg + (size_t)(row0 + ai * HALF + m * 16) * DM + col0;
#pragma unroll
                    for (int bj = 0; bj < 2; ++bj) { const f32x4 v0 = acc[ai][bj][m][0], v1 = acc[ai][bj][m][1]; u32x4 w; w.x = cvtpk(v0[0], v0[1]); w.y = cvtpk(v0[2], v0[3]); w.z = cvtpk(v1[0], v1[1]); w.w = cvtpk(v1[2], v1[3]);
                        *(u32x4*)(rowp + bj * HALF) = w; } }
        } else {
            const int col0 = (u.pn - 4) * HALF + wc * 32 + 8 * fq;
#pragma unroll
            for (int ai = 0; ai < 2; ++ai)
#pragma unroll
                for (int m = 0; m < 4; ++m) { bf16_t* rowp = U + (size_t)(row0 + ai * HALF + m * 16) * DM + col0;
                    const f32x4 v0 = acc[ai][0][m][0] * acc[ai][1][m][0], v1 = acc[ai][0][m][1] * acc[ai][1][m][1]; u32x4 w; w.x = cvtpk(v0[0], v0[1]); w.y = cvtpk(v0[2], v0[3]); w.z = cvtpk(v1[0], v1[1]); w.w = cvtpk(v1[2], v1[3]);
                    *(u32x4*)rowp = w; }
        }
    }
};
struct EpiRes {
    static constexpr bool PERM = false;
    const float* base; float* out;
    __device__ __forceinline__ void operator()(const f32x4 (&acc)[2][2][4][2], const Unit& u, int wr, int wc, int fr, int fq) const {
        const int col0 = u.pn * BM + wc * 32 + 4 * fq;
#pragma unroll
        for (int ai = 0; ai < 2; ++ai)
#pragma unroll
            for (int m = 0; m < 4; ++m) { const size_t off = (size_t)(u.pm * BM + ai * HALF + wr * 64 + m * 16 + fr) * DM + col0;
                f32x4 b[2][2];
#pragma unroll
                for (int bj = 0; bj < 2; ++bj)
#pragma unroll
                    for (int n = 0; n < 2; ++n) b[bj][n] = *(const f32x4*)(base + off + bj * HALF + n * 16);
#pragma unroll
                for (int bj = 0; bj < 2; ++bj)
#pragma unroll
                    for (int n = 0; n < 2; ++n) *(f32x4*)(out + off + bj * HALF + n * 16) = b[bj][n] + acc[ai][bj][m][n];
                if (m & 1) asm volatile("" ::: "memory"); }
    }
};
struct EpiQKV {
    static constexpr bool PERM = true;
    bf16_t* O; const _Float16* cosT; const _Float16* sinT; int tok0;
    __device__ __forceinline__ void operator()(const f32x4 (&acc)[2][2][4][2], const Unit& u, int wr, int wc, int fr, int fq) const {
        const int sec = u.pn >> 2, kind = sec % 3, head = (u.pn & 3) * 4 + wc;
        const int col = sec * 1024 + head * 64 + 8 * fq;
#pragma unroll
        for (int ai = 0; ai < 2; ++ai)
#pragma unroll
            for (int m = 0; m < 4; ++m) { const int rloc = u.pm * BM + ai * HALF + wr * 64 + m * 16 + fr;
                bf16_t* rowp = O + (size_t)rloc * QKVW + col;
                f32x4 a0 = acc[ai][0][m][0], a1 = acc[ai][0][m][1], b0 = acc[ai][1][m][0], b1 = acc[ai][1][m][1];
                if (kind < 2) {
                    const h16x8 cv = *(const h16x8*)(cosT + (size_t)(tok0 + rloc) * 32 + 8 * fq), sv = *(const h16x8*)(sinT + (size_t)(tok0 + rloc) * 32 + 8 * fq);
                    const float sc = kind == 0 ? C2 : 1.f;
#pragma unroll
                    for (int i = 0; i < 4; ++i) { const float c0 = (float)cv[i] * sc, s0 = (float)sv[i] * sc, c1 = (float)cv[4 + i] * sc, s1 = (float)sv[4 + i] * sc;
                        const float x1 = a0[i], x2 = b0[i], y1 = a1[i], y2 = b1[i];
                        a0[i] = x1 * c0 - x2 * s0; b0[i] = x2 * c0 + x1 * s0; a1[i] = y1 * c1 - y2 * s1; b1[i] = y2 * c1 + y1 * s1; }
                }
                u32x4 w; w.x = cvtpk(a0[0], a0[1]); w.y = cvtpk(a0[2], a0[3]); w.z = cvtpk(a1[0], a1[1]); w.w = cvtpk(a1[2], a1[3]); *(u32x4*)rowp = w;
                w.x = cvtpk(b0[0], b0[1]); w.y = cvtpk(b0[2], b0[3]); w.z = cvtpk(b1[0], b1[1]); w.w = cvtpk(b1[2], b1[3]); *(u32x4*)(rowp + 32) = w; }
    }
};
struct EpiMoeGU {
    static constexpr bool PERM = true;
    bf16_t* H;
    __device__ __forceinline__ void operator()(const f32x4 (&acc)[2][2][4][2], const Unit& u, int wr, int wc, int fr, int fq) const {
        const int col0 = u.pn * HALF + wc * 32 + 8 * fq;
#pragma unroll
        for (int ai = 0; ai < 2; ++ai)
#pragma unroll
            for (int m = 0; m < 4; ++m) { bf16_t* rowp = H + (size_t)(u.arow + ai * HALF + wr * 64 + m * 16 + fr) * 512 + col0;
                float o[8];
#pragma unroll
                for (int n = 0; n < 2; ++n)
#pragma unroll
                    for (int i = 0; i < 4; ++i) { const float gt = acc[ai][0][m][n][i], up = acc[ai][1][m][n][i];
                        o[n * 4 + i] = gt * __builtin_amdgcn_rcpf(1.f + __builtin_amdgcn_exp2f(-gt * LOG2E)) * up; }
                u32x4 w; w.x = cvtpk(o[0], o[1]); w.y = cvtpk(o[2], o[3]); w.z = cvtpk(o[4], o[5]); w.w = cvtpk(o[6], o[7]); *(u32x4*)rowp = w; }
    }
};
struct EpiMoeDown {
    static constexpr bool PERM = true;
    bf16_t* YS; const int* list; const float* gate;
    __device__ __forceinline__ void operator()(const f32x4 (&acc)[2][2][4][2], const Unit& u, int wr, int wc, int fr, int fq) const {
        const int col0 = u.pn * BM + wc * 32 + 8 * fq;
#pragma unroll
        for (int ai = 0; ai < 2; ++ai)
#pragma unroll
            for (int m = 0; m < 4; ++m) { const int pos = u.pm * BM + ai * HALF + wr * 64 + m * 16 + fr;
                if (pos < u.x1) { const int dst = list[u.x0 * 32768 + pos]; const float gw = gate[u.x0 * 32768 + pos];
                    bf16_t* rowp = YS + (size_t)dst * DM + col0;
#pragma unroll
                    for (int bj = 0; bj < 2; ++bj) { const f32x4 v0 = acc[ai][bj][m][0] * gw, v1 = acc[ai][bj][m][1] * gw; u32x4 w; w.x = cvtpk(v0[0], v0[1]); w.y = cvtpk(v0[2], v0[3]); w.z = cvtpk(v1[0], v1[1]); w.w = cvtpk(v1[2], v1[3]);
                        *(u32x4*)(rowp + bj * HALF) = w; } } }
    }
};

template <class Epi, class Sched, bool GATHER, bool ALIGN_EPI>
__device__ __forceinline__ void gemm_phase(LAS unsigned char* lds, const Gemm g, const Sched& S, const Epi& E, const int tid) {
    const int wid = __builtin_amdgcn_readfirstlane(tid >> 6), lane = tid & 63, wr = wid >> 2, wc = wid & 3, fr = lane & 15, fq = lane >> 4;
    const int K = g.K, nt = K / BK;
    unsigned voffA[2], voffB[2]; int RA[2]; unsigned CA2[2];
#pragma unroll
    for (int i = 0; i < 2; ++i) { int R, C; stage_rc(tid * 16 + i * 8192, R, C); const int Rb = Epi::PERM ? ((R & ~31) + perm32(R & 31)) : R;
        voffA[i] = (unsigned)(R * K + C) * 2u; voffB[i] = (unsigned)(Rb * K + C) * 2u; RA[i] = R; CA2[i] = (unsigned)C * 2u; }
    const size_t kstep = (size_t)(BK * 2);
    const size_t hstep = (size_t)HALF * K * 2;
    const size_t hstepA = GATHER ? (size_t)0 : hstep;
    const unsigned ldsw = (unsigned)wid * 1024u;
    const int aoff = lds_byte(wr * 64 + fr, fq * 8), boff = lds_byte(wc * 32 + fr, fq * 8);
#define PG8_SA(b, h) (((b) * 2 + (h)) * HTB)
#define PG8_SB(b, h) ((4 + (b) * 2 + (h)) * HTB)
#define PG8_STAGE(bufoff, gbase, voff) do { _Pragma("unroll") for (int _i = 0; _i < 2; ++_i) \
        __builtin_amdgcn_global_load_lds((const unsigned*)((const char*)(gbase) + (voff)[_i]), (LAS unsigned*)(lds + (bufoff) + ldsw + _i * 8192), 16, 0, 0); } while (0)
#define PG8_STAGE_A0(bufoff, ptr, V0) PG8_STAGE(bufoff, ptr, V0)
#define PG8_STAGE_A1(bufoff, ptr, V1) PG8_STAGE(bufoff, (ptr) + hstepA, V1)
#define PG8_LDA(dst, b, h) do { _Pragma("unroll") for (int m = 0; m < 4; ++m) _Pragma("unroll") for (int k = 0; k < 2; ++k) dst[m][k] = *(const LAS bf16x8*)(lds + PG8_SA(b, h) + aoff + m * 2048 + k * 1024); } while (0)
#define PG8_LDB(dst, b, h) do { _Pragma("unroll") for (int n = 0; n < 2; ++n) _Pragma("unroll") for (int k = 0; k < 2; ++k) dst[n][k] = *(const LAS bf16x8*)(lds + PG8_SB(b, h) + boff + n * 2048 + k * 1024); } while (0)
#define PG8_MMA(ai, bj, At, Bt) do { __builtin_amdgcn_s_setprio(1); _Pragma("unroll") for (int m = 0; m < 4; ++m) _Pragma("unroll") for (int n = 0; n < 2; ++n) _Pragma("unroll") for (int k = 0; k < 2; ++k) \
        acc[ai][bj][m][n] = __builtin_amdgcn_mfma_f32_16x16x32_bf16(Bt[n][k], At[m][k], acc[ai][bj][m][n], 0, 0, 0); __builtin_amdgcn_s_setprio(0); } while (0)
#define PG8_WAIT_V(n) asm volatile("s_waitcnt vmcnt(" #n ")" ::: "memory")
#define PG8_WAIT_L(n) asm volatile("s_waitcnt lgkmcnt(" #n ")" ::: "memory")
#define PG8_BAR __builtin_amdgcn_s_barrier()
#define PG8_SCHED __builtin_amdgcn_sched_barrier(0)
    Unit cur, nxt; int ui = 0;
    if (!S.next(0, cur)) return;
    f32x4 acc[2][2][4][2];
#pragma unroll
    for (int a = 0; a < 2; ++a)
#pragma unroll
        for (int b = 0; b < 2; ++b)
#pragma unroll
            for (int m = 0; m < 4; ++m)
#pragma unroll
                for (int n = 0; n < 2; ++n) acc[a][b][m][n] = (f32x4){0.f, 0.f, 0.f, 0.f};
    bf16x8 At[4][2], B0[2][2], B1[2][2];
    unsigned vc0[2], vc1[2], vn0[2], vn1[2];
    if constexpr (GATHER) {
#pragma unroll
        for (int i = 0; i < 2; ++i) { vc0[i] = S.arow_of(cur, RA[i]) * (unsigned)(K * 2) + CA2[i]; vc1[i] = S.arow_of(cur, HALF + RA[i]) * (unsigned)(K * 2) + CA2[i]; }
        __builtin_amdgcn_s_waitcnt(0x0F70);
    } else {
#pragma unroll
        for (int i = 0; i < 2; ++i) { vc0[i] = voffA[i]; vc1[i] = voffA[i]; }
    }
#pragma unroll
    for (int i = 0; i < 2; ++i) { vn0[i] = vc0[i]; vn1[i] = vc1[i]; }
    const char* cA = (const char*)g.A + (GATHER ? (size_t)0 : (size_t)cur.arow * K * 2); const char* cB = (const char*)g.Bt + (size_t)cur.brow * K * 2;
    PG8_STAGE(PG8_SB(0, 0), cB, voffB); PG8_STAGE(PG8_SB(0, 1), cB + hstep, voffB); PG8_STAGE_A0(PG8_SA(0, 0), cA, vc0); PG8_STAGE_A1(PG8_SA(0, 1), cA, vc1);
    if (wr == 1) PG8_BAR;
    PG8_WAIT_V(2); PG8_BAR;
    PG8_STAGE(PG8_SB(1, 0), cB + kstep, voffB); PG8_STAGE_A0(PG8_SA(1, 0), cA + kstep, vc0); PG8_STAGE(PG8_SB(1, 1), cB + hstep + kstep, voffB);
    PG8_WAIT_V(6); PG8_BAR;
    for (;;) {
        const bool has_next = S.next(ui + 1, nxt);
        const char* nA = has_next ? (const char*)g.A + (GATHER ? (size_t)0 : (size_t)nxt.arow * K * 2) : cA; const char* nB = has_next ? (const char*)g.Bt + (size_t)nxt.brow * K * 2 : cB;
        if constexpr (GATHER) {
            if (has_next) {
#pragma unroll
                for (int i = 0; i < 2; ++i) { vn0[i] = S.arow_of(nxt, RA[i]) * (unsigned)(K * 2) + CA2[i]; vn1[i] = S.arow_of(nxt, HALF + RA[i]) * (unsigned)(K * 2) + CA2[i]; }
                __builtin_amdgcn_s_waitcnt(0x0F70);
            }
        }
        for (int t = 0; t < nt; t += 2) {
            const bool last = (t == nt - 2);
            const char* a1 = cA + (size_t)(t + 1) * kstep;
            const char* a2 = last ? nA : cA + (size_t)(t + 2) * kstep; const char* b2 = last ? nB : cB + (size_t)(t + 2) * kstep;
            const char* a3 = a2 + kstep; const char* b3 = b2 + kstep;
            unsigned vx0[2], vx1[2];
#pragma unroll
            for (int i = 0; i < 2; ++i) { vx0[i] = (GATHER && last) ? vn0[i] : vc0[i]; vx1[i] = (GATHER && last) ? vn1[i] : vc1[i]; }
            PG8_LDB(B0, 0, 0); PG8_LDB(B1, 0, 1); PG8_SCHED; PG8_LDA(At, 0, 0); PG8_STAGE_A1(PG8_SA(1, 1), a1, vc1);
            PG8_WAIT_V(8); PG8_WAIT_L(0); PG8_BAR; PG8_MMA(0, 0, At, B0); PG8_MMA(0, 1, At, B1); PG8_BAR; PG8_SCHED;
            PG8_LDA(At, 0, 1); PG8_STAGE(PG8_SB(0, 0), b2, voffB); PG8_STAGE(PG8_SB(0, 1), b2 + hstep, voffB); PG8_STAGE_A0(PG8_SA(0, 0), a2, vx0);
            PG8_WAIT_V(8); PG8_WAIT_L(0); PG8_BAR; PG8_MMA(1, 0, At, B0); PG8_MMA(1, 1, At, B1); PG8_BAR; PG8_SCHED;
            PG8_LDB(B0, 1, 0); PG8_LDB(B1, 1, 1); PG8_SCHED; PG8_LDA(At, 1, 0); PG8_STAGE_A1(PG8_SA(0, 1), a2, vx1);
            PG8_WAIT_V(8); PG8_WAIT_L(0); PG8_BAR; PG8_MMA(0, 0, At, B0); PG8_MMA(0, 1, At, B1); PG8_BAR; PG8_SCHED;
            PG8_LDA(At, 1, 1); PG8_STAGE(PG8_SB(1, 0), b3, voffB); PG8_STAGE(PG8_SB(1, 1), b3 + hstep, voffB); PG8_STAGE_A0(PG8_SA(1, 0), a3, vx0);
            PG8_WAIT_V(8); PG8_WAIT_L(0); PG8_BAR; PG8_MMA(1, 0, At, B0); PG8_MMA(1, 1, At, B1); PG8_BAR; PG8_SCHED;
        }
        if constexpr (ALIGN_EPI) { if (wr == 0) PG8_BAR; }
        E(acc, cur, wr, wc, fr, fq);
        if (!has_next) break;
#pragma unroll
        for (int a = 0; a < 2; ++a)
#pragma unroll
            for (int b = 0; b < 2; ++b)
#pragma unroll
                for (int m = 0; m < 4; ++m)
#pragma unroll
                    for (int n = 0; n < 2; ++n) acc[a][b][m][n] = (f32x4){0.f, 0.f, 0.f, 0.f};
        cur = nxt; cA = nA; cB = nB; ++ui;
#pragma unroll
        for (int i = 0; i < 2; ++i) { vc0[i] = vn0[i]; vc1[i] = vn1[i]; }
        if constexpr (ALIGN_EPI) { if (wr == 1) PG8_BAR; }
    }
    PG8_WAIT_V(0);
    if constexpr (!ALIGN_EPI) { if (wr == 0) PG8_BAR; }
    PG8_BAR;
#undef PG8_SA
#undef PG8_SB
#undef PG8_STAGE
#undef PG8_STAGE_A0
#undef PG8_STAGE_A1
#undef PG8_LDA
#undef PG8_LDB
#undef PG8_MMA
#undef PG8_WAIT_V
#undef PG8_WAIT_L
#undef PG8_BAR
#undef PG8_SCHED
}
}

typedef GAS unsigned gu32;
#define RLX_AGENT __ATOMIC_RELAXED, __HIP_MEMORY_SCOPE_AGENT
#define XB_TMO      128
#define XB_XCNT(j)  (256  + 64 * (j))
#define XB_XSUB(j)  (1280 + 64 * (j))
#define XB_XGEN(j)  (2304 + 64 * (j))
#define XB_TOP      3328
#define XB_TOPGEN   3392
#define XCD_BAR_WORDS 3456
#define XB_SPIN_CAP (1u << 20)
__device__ __forceinline__ unsigned xb_ld(unsigned* p)              { return __hip_atomic_load(p, __ATOMIC_RELAXED, __HIP_MEMORY_SCOPE_AGENT); }
__device__ __forceinline__ unsigned xb_add(unsigned* p, unsigned v) { return __hip_atomic_fetch_add(p, v, __ATOMIC_RELAXED, __HIP_MEMORY_SCOPE_AGENT); }
__device__ __forceinline__ unsigned xb_xcc_id() { return (unsigned)__builtin_amdgcn_s_getreg((3 << 11) | 20) & 0xFu; }
#define XB_SPIN(cond, bar) do { unsigned _sp = 0; while (cond) { __builtin_amdgcn_s_sleep(1); \
    if ((++_sp & 255u) == 0u) { if (xb_ld(&(bar)[XB_TMO])) break; if (_sp > XB_SPIN_CAP) { atomicAdd(&(bar)[XB_TMO], 1u); break; } } } } while (0)
struct XcdBarrier { unsigned* bar; unsigned x; volatile LAS unsigned* st; };
__device__ __forceinline__ XcdBarrier xcd_barrier_post(unsigned* bar, volatile LAS unsigned* st) {
    XcdBarrier b; b.bar = bar; b.x = xb_xcc_id(); b.st = st;
    if (threadIdx.x == 0) (void)xb_add(&bar[XB_XCNT(b.x)], 1u);
    return b;
}
__device__ __forceinline__ void xcd_barrier_complete(unsigned* bar, unsigned x, unsigned& nloc, unsigned& nx) {
    const unsigned G = gridDim.x * gridDim.y * gridDim.z;
    unsigned sum, cnt, mine, sp = 0u;
    for (;;) {
        sum = 0u; cnt = 0u; mine = 0u;
#pragma unroll
        for (unsigned j = 0; j < 16; ++j) { const unsigned c = xb_ld(&bar[XB_XCNT(j)]); sum += c; cnt += (c > 0u) ? 1u : 0u; mine = (j == x) ? c : mine; }
        if (sum == G) break;
        __builtin_amdgcn_s_sleep(1);
        if ((++sp & 255u) == 0u) { if (xb_ld(&bar[XB_TMO])) break; if (sp > XB_SPIN_CAP) { atomicAdd(&bar[XB_TMO], 1u); break; } }
    }
    nloc = mine > 0u ? mine : 1u; nx = cnt > 0u ? cnt : 1u;
}
__device__ __forceinline__ void xcd_barrier(const XcdBarrier& b) {
    asm volatile("s_waitcnt vmcnt(0)" ::: "memory");
    __syncthreads();
    if (threadIdx.x == 0) {
        unsigned* bar = b.bar;
        __builtin_amdgcn_s_waitcnt(0);
        unsigned nloc = b.st[0], nx = b.st[1];
        if (nloc == 0u) { xcd_barrier_complete(bar, b.x, nloc, nx); b.st[0] = nloc; b.st[1] = nx; }
        const unsigned old = xb_add(&bar[XB_XSUB(b.x)], 1u);
        const unsigned gen = old / nloc;
        if (old + 1u == (gen + 1u) * nloc) {
            __builtin_amdgcn_fence(__ATOMIC_RELEASE, "agent");
            asm volatile("s_waitcnt vmcnt(0)" ::: "memory");
            const unsigned og = xb_add(&bar[XB_TOP], 1u);
            const unsigned tg = og / nx;
            if (og + 1u == (tg + 1u) * nx) xb_add(&bar[XB_TOPGEN], 1u);
            else XB_SPIN(xb_ld(&bar[XB_TOPGEN]) == tg, bar);
            __builtin_amdgcn_fence(__ATOMIC_ACQUIRE, "agent");
            xb_add(&bar[XB_XGEN(b.x)], 1u);
            asm volatile("s_waitcnt vmcnt(0)" ::: "memory");
        } else {
            XB_SPIN(xb_ld(&bar[XB_XGEN(b.x)]) == gen, bar);
            __builtin_amdgcn_fence(__ATOMIC_ACQUIRE, "agent");
            asm volatile("s_waitcnt vmcnt(0)" ::: "memory");
        }
    }
    __syncthreads();
}

struct Args {
    const float* x; const int* pos; const float* norm_mix; const float* norm_ffn; const float* norm_final;
    const float* conv_w_in; const float* conv_w; const float* conv_w_out; const float* attn_w_qkv; const float* attn_w_o;
    const float* w_coarse; const float* b_coarse; const float* w_fine; const float* b_fine; const float* w_gate; const float* w_up; const float* w_down;
    float* out; unsigned char* ws; int ph_lo, ph_hi;
};

__constant__ double INVREV[32] = {0.15915494309189535, 0.11934937021124886, 0.08949940160889101, 0.06711508300522726, 0.050329212104487035, 0.03774158471741977, 0.0283021958306234, 0.02122365276477766,
    0.015915494309189534, 0.011934937021124886, 0.008949940160889102, 0.006711508300522725, 0.005032921210448704, 0.003774158471741977, 0.00283021958306234, 0.0021223652764777662,
    0.0015915494309189536, 0.0011934937021124885, 0.0008949940160889102, 0.0006711508300522726, 0.0005032921210448703, 0.00037741584717419774, 0.00028302195830623395, 0.0002122365276477766,
    0.00015915494309189535, 0.00011934937021124886, 8.949940160889102e-05, 6.711508300522725e-05, 5.0329212104487035e-05, 3.774158471741978e-05, 2.8302195830623396e-05, 2.122365276477766e-05};

__device__ __forceinline__ int dest_row(int mode, int n0) {
    switch (mode) {
        default: return n0;
        case 1: { const int s = n0 >> 10, j = n0 & 1023; if (s == 0) return j; const int q = j >> 7; return 1024 + 256 * q + (s == 2 ? 128 : 0) + (j & 127); }
        case 2: { const int sec = n0 >> 10, j = n0 & 1023, head = j >> 6, d = j & 63, tile = head >> 2, hit = head & 3, bj = d >> 5, dd = d & 31; return sec * 1024 + tile * 256 + bj * 128 + hit * 32 + dd; }
        case 3: { const int pn = n0 >> 7; return 256 * pn + (n0 & 127); }
        case 4: { const int pn = n0 >> 7; return 256 * pn + 128 + (n0 & 127); }
    }
}
__device__ __forceinline__ void transpose_item(const float* W, int K, int N, bf16_t* WT, int mode, LAS float* scr, int item, int lane) {
    const int nblk = N / 64, kb = item / nblk, nb = item % nblk, k0 = 64 * kb, n0 = 64 * nb;
#pragma unroll 4
    for (int i = 0; i < 16; ++i) { const int kk = 4 * i + (lane >> 4), nn = 4 * (lane & 15); const f32x4 v = *(const f32x4*)(W + (size_t)(k0 + kk) * N + n0 + nn);
        LAS float* s = scr + kk * 65 + nn; s[0] = v[0]; s[1] = v[1]; s[2] = v[2]; s[3] = v[3]; }
    LDS_WAIT(); asm volatile("" ::: "memory");
    const int c = lane & 7;
#pragma unroll
    for (int j = 0; j < 8; ++j) { const int n = (lane >> 3) + 8 * j; const LAS float* s = scr + (8 * c) * 65 + n;
        u32x4 o; o.x = cvtpk(s[0 * 65], s[1 * 65]); o.y = cvtpk(s[2 * 65], s[3 * 65]); o.z = cvtpk(s[4 * 65], s[5 * 65]); o.w = cvtpk(s[6 * 65], s[7 * 65]);
        const int dr = dest_row(mode, n0 + (n & 32)) + (n & 31);
        *(u32x4*)(WT + (size_t)dr * K + k0 + 8 * c) = o; }
    LDS_WAIT(); asm volatile("" ::: "memory");
}

template <int MODE>
__device__ __forceinline__ void norm_rows(const float* src, float* out, const bf16_t* YS, const float* gw, bf16_t* HN, int gw_id, int lane) {
    f32x4 gv[4];
#pragma unroll
    for (int j = 0; j < 4; ++j) gv[j] = *(const f32x4*)(gw + 4 * lane + 256 * j);
    for (int rr = 0; rr < 16; ++rr) {
        const int row = gw_id * 16 + rr;
        const f32x4* xr = (const f32x4*)(src + (size_t)row * DM) + lane;
        f32x4 v[4];
#pragma unroll
        for (int j = 0; j < 4; ++j) v[j] = xr[64 * j];
        if (MODE != 0) {
            const u32x2* y0 = (const u32x2*)(YS + (size_t)(2 * row) * DM) + lane; const u32x2* y1 = (const u32x2*)(YS + (size_t)(2 * row + 1) * DM) + lane;
#pragma unroll
            for (int j = 0; j < 4; ++j) { const u32x2 a = y0[64 * j], b = y1[64 * j];
                v[j][0] += bflo(a.x) + bflo(b.x); v[j][1] += bfhi(a.x) + bfhi(b.x); v[j][2] += bflo(a.y) + bflo(b.y); v[j][3] += bfhi(a.y) + bfhi(b.y); }
        }
        float s = 0.f;
#pragma unroll
        for (int j = 0; j < 4; ++j) s += (v[j][0] * v[j][0] + v[j][1] * v[j][1]) + (v[j][2] * v[j][2] + v[j][3] * v[j][3]);
        const float rstd = 1.0f / sqrtf(wave_sum(s) * (1.f / DM) + EPS);
        if (MODE == 1) { f32x4* o = (f32x4*)(out + (size_t)row * DM) + lane;
#pragma unroll
            for (int j = 0; j < 4; ++j) o[64 * j] = v[j]; }
        if (MODE == 2) { f32x4* o = (f32x4*)(out + (size_t)row * DM) + lane;
#pragma unroll
            for (int j = 0; j < 4; ++j) o[64 * j] = v[j] * rstd * gv[j]; }
        else { u32x2* o8 = (u32x2*)(HN + (size_t)row * DM) + lane;
#pragma unroll
            for (int j = 0; j < 4; ++j) { const f32x4 t = v[j] * rstd * gv[j]; u32x2 w; w.x = cvtpk(t[0], t[1]); w.y = cvtpk(t[2], t[3]); o8[64 * j] = w; } }
    }
}

constexpr int RT_WC = 0, RT_WF = 16384, RT_CNT = 81920, RT_BASE = RT_CNT + 64, RT_INFO = RT_BASE + 64;
__device__ __forceinline__ void route_phase(LAS unsigned char* lds, const float* h, const float* gw, bf16_t* HN, const float* w_coarse, const float* b_coarse, const float* w_fine, const float* b_fine,
                                            unsigned* gcnt, int* list, float* gate, int gw_id, int wave, int lane, int tid) {
    LAS f32x4* wcL = (LAS f32x4*)(lds + RT_WC); LAS f32x4* wfL = (LAS f32x4*)(lds + RT_WF);
    LAS int* cntL = (LAS int*)(lds + RT_CNT); LAS int* baseL = (LAS int*)(lds + RT_BASE); LAS int* info = (LAS int*)(lds + RT_INFO);
    for (int k = tid; k < 1024; k += 512) { const int l = (k & 255) >> 2, j = k >> 8, i = k & 3; wcL[(j * 4 + i) * 64 + l] = *(const f32x4*)(w_coarse + 4 * k);
#pragma unroll
        for (int g = 0; g < 4; ++g) wfL[g * 1024 + (j * 4 + i) * 64 + l] = *(const f32x4*)(w_fine + (size_t)g * 4096 + 4 * k); }
    if (tid < 16) cntL[tid] = 0;
    __syncthreads();
    f32x4 gv[4];
#pragma unroll
    for (int j = 0; j < 4; ++j) gv[j] = *(const f32x4*)(gw + 4 * lane + 256 * j);
    const f32x4 bc = *(const f32x4*)b_coarse;
    for (int rr = 0; rr < 16; ++rr) {
        const int row = gw_id * 16 + rr;
        const f32x4* xr = (const f32x4*)(h + (size_t)row * DM) + lane;
        f32x4 v[4];
#pragma unroll
        for (int j = 0; j < 4; ++j) v[j] = xr[64 * j];
        float s = 0.f;
#pragma unroll
        for (int j = 0; j < 4; ++j) s += (v[j][0] * v[j][0] + v[j][1] * v[j][1]) + (v[j][2] * v[j][2] + v[j][3] * v[j][3]);
        const float rstd = 1.0f / sqrtf(wave_sum(s) * (1.f / DM) + EPS);
        u32x2* o8 = (u32x2*)(HN + (size_t)row * DM) + lane;
#pragma unroll
        for (int j = 0; j < 4; ++j) { v[j] = v[j] * rstd * gv[j]; u32x2 w; w.x = cvtpk(v[j][0], v[j][1]); w.y = cvtpk(v[j][2], v[j][3]); o8[64 * j] = w; }
        f32x4 pc = {0.f, 0.f, 0.f, 0.f};
#pragma unroll
        for (int j = 0; j < 4; ++j)
#pragma unroll
            for (int i = 0; i < 4; ++i) pc += wcL[(j * 4 + i) * 64 + lane] * v[j][i];
        float c0 = wave_sum(pc[0]) + bc[0], c1 = wave_sum(pc[1]) + bc[1], c2 = wave_sum(pc[2]) + bc[2], c3 = wave_sum(pc[3]) + bc[3];
        int gt = 0; float cm = c0; if (c1 > cm) { cm = c1; gt = 1; } if (c2 > cm) { cm = c2; gt = 2; } if (c3 > cm) { cm = c3; gt = 3; }
        const float ptop = 1.0f / (__expf(c0 - cm) + __expf(c1 - cm) + __expf(c2 - cm) + __expf(c3 - cm));
        gt = __builtin_amdgcn_readfirstlane(gt);
        f32x4 pf = {0.f, 0.f, 0.f, 0.f};
        const LAS f32x4* wfg = wfL + gt * 1024;
#pragma unroll
        for (int j = 0; j < 4; ++j)
#pragma unroll
            for (int i = 0; i < 4; ++i) pf += wfg[(j * 4 + i) * 64 + lane] * v[j][i];
        const f32x4 bf = *(const f32x4*)(b_fine + 4 * gt);
        float f[4]; f[0] = wave_sum(pf[0]) + bf[0]; f[1] = wave_sum(pf[1]) + bf[1]; f[2] = wave_sum(pf[2]) + bf[2]; f[3] = wave_sum(pf[3]) + bf[3];
        int i0 = 0; float m0 = f[0];
#pragma unroll
        for (int i = 1; i < 4; ++i) if (f[i] > m0) { m0 = f[i]; i0 = i; }
        int i1 = -1; float m1 = -INFINITY;
#pragma unroll
        for (int i = 0; i < 4; ++i) if (i != i0 && f[i] > m1) { m1 = f[i]; i1 = i; }
        const float ex = __expf(m1 - m0), den = 1.0f / (1.0f + ex);
        const float g0 = ptop * den, g1 = ptop * ex * den;
        if (lane == 0) { const int e0 = gt * 4 + i0, e1 = gt * 4 + i1;
            const int p0 = __hip_atomic_fetch_add(&cntL[e0], 1, __ATOMIC_RELAXED, __HIP_MEMORY_SCOPE_WORKGROUP);
            const int p1 = __hip_atomic_fetch_add(&cntL[e1], 1, __ATOMIC_RELAXED, __HIP_MEMORY_SCOPE_WORKGROUP);
            LAS int* inf = info + (wave * 16 + rr) * 8; inf[0] = e0; inf[1] = p0; inf[2] = __float_as_int(g0); inf[3] = e1; inf[4] = p1; inf[5] = __float_as_int(g1); inf[6] = row; }
    }
    __syncthreads();
    if (tid < 16) baseL[tid] = (int)__hip_atomic_fetch_add(gcnt + tid, (unsigned)cntL[tid], __ATOMIC_RELAXED, __HIP_MEMORY_SCOPE_AGENT);
    __syncthreads();
    if (tid < 128) { const LAS int* inf = info + tid * 8; const int e0 = inf[0], e1 = inf[3], row = inf[6];
        const int q0 = baseL[e0] + inf[1], q1 = baseL[e1] + inf[4];
        list[e0 * 32768 + q0] = row * 2; gate[e0 * 32768 + q0] = __int_as_float(inf[2]);
        list[e1 * 32768 + q1] = row * 2 + 1; gate[e1 * 32768 + q1] = __int_as_float(inf[5]); }
    __syncthreads();
}

__device__ __forceinline__ void conv_phase(const bf16_t* Bg, const bf16_t* U, bf16_t* Y, const float* cw  , int gw_id, int lane) {
    const int rb = gw_id >> 1, c0 = (gw_id & 1) * 512 + lane * 8, t0 = rb * 32;
    float w0[8], w1[8], w2[8];
#pragma unroll
    for (int i = 0; i < 8; ++i) { w0[i] = cw[c0 + i]; w1[i] = cw[1024 + c0 + i]; w2[i] = cw[2048 + c0 + i]; }
    float um1[8], um2[8];
    const bool hasprev = (t0 & (SEQ - 1)) != 0;
    { u32x4 a = {0u, 0u, 0u, 0u}, b = {0u, 0u, 0u, 0u};
      if (hasprev) { a = *(const u32x4*)(U + (size_t)(t0 - 1) * DM + c0); b = *(const u32x4*)(U + (size_t)(t0 - 2) * DM + c0); }
#pragma unroll
      for (int i = 0; i < 4; ++i) { um1[2 * i] = bflo(a[i]); um1[2 * i + 1] = bfhi(a[i]); um2[2 * i] = bflo(b[i]); um2[2 * i + 1] = bfhi(b[i]); } }
#pragma unroll 4
    for (int t = 0; t < 32; ++t) {
        const u32x4 uu = *(const u32x4*)(U + (size_t)(t0 + t) * DM + c0), bb = *(const u32x4*)(Bg + (size_t)(t0 + t) * DM + c0);
        float uc[8], bg[8], y[8];
#pragma unroll
        for (int i = 0; i < 4; ++i) { uc[2 * i] = bflo(uu[i]); uc[2 * i + 1] = bfhi(uu[i]); bg[2 * i] = bflo(bb[i]); bg[2 * i + 1] = bfhi(bb[i]); }
#pragma unroll
        for (int i = 0; i < 8; ++i) { y[i] = bg[i] * (w0[i] * um2[i] + w1[i] * um1[i] + w2[i] * uc[i]); um2[i] = um1[i]; um1[i] = uc[i]; }
        u32x4 o; o.x = cvtpk(y[0], y[1]); o.y = cvtpk(y[2], y[3]); o.z = cvtpk(y[4], y[5]); o.w = cvtpk(y[6], y[7]);
        *(u32x4*)(Y + (size_t)(t0 + t) * DM + c0) = o;
    }
}

__device__ __forceinline__ int crow(int r, int hi) { return (r & 3) + 8 * (r >> 2) + 4 * hi; }
__device__ __forceinline__ s16x4 vtr(const LAS char* p) { typedef short v4i16_t __attribute__((ext_vector_type(4))); return __builtin_bit_cast(s16x4, __builtin_amdgcn_ds_read_tr16_b64_v4i16((LAS v4i16_t*)p)); }
constexpr int AT_WAVE_BYTES = 12544;
constexpr int AT_LSE = 8 * AT_WAVE_BYTES;
__device__ __forceinline__ void attn_wave_unit(bf16_t* QKVh, int b, int h, int g, int r, int a0, int sh, LAS char* wl, LAS float* lseG, int tl0, int lane) {
    const int r32 = lane & 31, hi = lane >> 5;
    bf16_t* base = QKVh + ((size_t)(b * SEQ + r) * QKVW + g * 3072 + h * 64);
    const size_t rs = (size_t)QKVW << sh;
    bf16x8 qr[4];
    { const bf16_t* qp = base + (size_t)(a0 + r32) * rs + hi * 8;
#pragma unroll
      for (int d0 = 0; d0 < 4; ++d0) qr[d0] = *(const bf16x8*)(qp + d0 * 16); }
    const int jmin = a0 >= 128 ? 0 : 4 - (a0 >> 5);
    f32x16 s[5];
#pragma unroll
    for (int j = 0; j < 5; ++j) {
        if (j >= jmin) {
            const bf16_t* kp = base + (size_t)(a0 - 128 + 32 * j + r32) * rs + 1024 + hi * 8;
            bf16x8 kf[4];
#pragma unroll
            for (int d0 = 0; d0 < 4; ++d0) kf[d0] = *(const bf16x8*)(kp + d0 * 16);
            f32x16 a = {0.f, 0.f, 0.f, 0.f, 0.f, 0.f, 0.f, 0.f, 0.f, 0.f, 0.f, 0.f, 0.f, 0.f, 0.f, 0.f};
#pragma unroll
            for (int d0 = 0; d0 < 4; ++d0) a = __builtin_amdgcn_mfma_f32_32x32x16_bf16(kf[d0], qr[d0], a, 0, 0, 0);
            s[j] = a;
        } else {
#pragma unroll
            for (int q = 0; q < 16; ++q) s[j][q] = -INFINITY;
        }
    }
#pragma unroll
    for (int q = 0; q < 16; ++q) { const int cr = crow(q, hi); if (cr < r32) s[0][q] = -INFINITY; if (cr > r32) s[4][q] = -INFINITY; }
    float mx = -INFINITY;
#pragma unroll
    for (int j = 0; j < 5; ++j)
#pragma unroll
        for (int q = 0; q < 16; ++q) mx = fmaxf(mx, s[j][q]);
    { auto rr = __builtin_amdgcn_permlane32_swap(__float_as_uint(mx), __float_as_uint(mx), false, false); mx = fmaxf(__uint_as_float(rr[0]), __uint_as_float(rr[1])); }
    float l = 0.f;
    u32x4 pw[5][2];
#pragma unroll
    for (int j = 0; j < 5; ++j) {
#pragma unroll
        for (int q = 0; q < 16; ++q) { s[j][q] = __builtin_amdgcn_exp2f(s[j][q] - mx); l += s[j][q]; }
        pw[j][0] = (u32x4){cvtpk(s[j][0], s[j][1]), cvtpk(s[j][2], s[j][3]), cvtpk(s[j][4], s[j][5]), cvtpk(s[j][6], s[j][7])};
        pw[j][1] = (u32x4){cvtpk(s[j][8], s[j][9]), cvtpk(s[j][10], s[j][11]), cvtpk(s[j][12], s[j][13]), cvtpk(s[j][14], s[j][15])};
    }
    { auto rr = __builtin_amdgcn_permlane32_swap(__float_as_uint(l), __float_as_uint(l), false, false); l = __uint_as_float(rr[0]) + __uint_as_float(rr[1]); }
    f32x16 o[2];
#pragma unroll
    for (int q = 0; q < 16; ++q) { o[0][q] = 0.f; o[1][q] = 0.f; }
#pragma unroll
    for (int j = 0; j < 5; ++j) {
        if (j >= jmin) {
            LAS char* vb = wl + (j & 1) * 4096;
#pragma unroll
            for (int p = 0; p < 4; ++p) { const int row = p * 8 + (lane >> 3), ch = lane & 7;
                const u32x4 v = *(const u32x4*)(base + (size_t)(a0 - 128 + 32 * j + row) * rs + 2048 + ch * 8);
                *(LAS u32x4*)(vb + (ch >> 2) * 2048 + row * 64 + (ch & 3) * 16) = v; }
            const LAS char* vp = vb + ((lane >> 4) & 1) * 32 + (lane & 3) * 8 + (4 * hi + ((lane & 15) >> 2)) * 64;
#pragma unroll
            for (int ks = 0; ks < 2; ++ks)
#pragma unroll
                for (int d0 = 0; d0 < 2; ++d0) { const s16x4 lo = vtr(vp + d0 * 2048 + ks * 1024), hh = vtr(vp + d0 * 2048 + ks * 1024 + 512);
                    const bf16x8 vf = (bf16x8){lo[0], lo[1], lo[2], lo[3], hh[0], hh[1], hh[2], hh[3]};
                    o[d0] = __builtin_amdgcn_mfma_f32_32x32x16_bf16(__builtin_bit_cast(bf16x8, pw[j][ks]), vf, o[d0], 0, 0, 0); }
        }
    }
    LAS float* wsf = (LAS float*)(wl + 12288);
    LAS bf16_t* stg = (LAS bf16_t*)(wl + 8192);
    if (hi == 0) { wsf[r32] = l; lseG[tl0 + (r32 << sh)] = mx + __builtin_amdgcn_logf(l); }
#pragma unroll
    for (int q = 0; q < 16; ++q) { const int orow = crow(q, hi); const float rl = __builtin_amdgcn_rcpf(wsf[orow]);
#pragma unroll
        for (int d0 = 0; d0 < 2; ++d0) { const unsigned pk = cvtpk(o[d0][q] * rl, 0.f); stg[orow * 64 + d0 * 32 + r32] = (bf16_t)(pk & 0xffffu); } }
#pragma unroll
    for (int i = 0; i < 4; ++i) { const int row = i * 8 + (lane >> 3), ch = lane & 7; const u32x4 v = *(const LAS u32x4*)(stg + row * 64 + ch * 8);
        *(u32x4*)(base + (size_t)(a0 + row) * rs + ch * 8) = v; }
}
__device__ __forceinline__ void ld16_sc1x3(const void* p0, const void* p1, const void* p2, u32x4& a, u32x4& b, u32x4& c) {
    asm volatile("global_load_dwordx4 %0, %3, off sc1\n\tglobal_load_dwordx4 %1, %4, off sc1\n\tglobal_load_dwordx4 %2, %5, off sc1\n\ts_waitcnt vmcnt(0)"
                 : "=&v"(a), "=&v"(b), "=&v"(c) : "v"(p0), "v"(p1), "v"(p2) : "memory");
}
__device__ __forceinline__ void attn_phase(LAS unsigned char* lds, bf16_t* QKVh, bf16_t* Oh  , int vcu, int wave, int lane) {
    LAS char* wl = (LAS char*)lds + wave * AT_WAVE_BYTES;
    for (int uu = 0; uu < 2; ++uu) {
        const int q = vcu * 2 + uu;
        const int b = q >> 7, h = (q >> 3) & 15, span = q & 7;
        LAS float* lseL = (LAS float*)(lds + AT_LSE) + uu * 1536;
        for (int i = 0; i < 6; ++i) {
            const int U = wave + 8 * i, g = U >> 4, idx = U & 15, sh = 2 * g;
            const int nblk_sh = 4 - sh;
            const int r = idx >> nblk_sh, blk = idx & ((1 << nblk_sh) - 1);
            const int a0 = span * (512 >> sh) + blk * 32;
            const int tl0 = ((blk * 32) << sh) + r;
            attn_wave_unit(QKVh, b, h, g, r, a0, sh, wl, lseL + g * 512, tl0, lane);
        }
        VM_WAIT(); LDS_WAIT();
        __syncthreads();
#pragma unroll 2
        for (int it = 0; it < 8; ++it) {
            const int tl = wave * 64 + it * 8 + (lane >> 3), ch = lane & 7;
            const size_t tok = (size_t)b * SEQ + span * 512 + tl;
            const bf16_t* p = QKVh + tok * QKVW + h * 64 + ch * 8;
            u32x4 o0, o1, o2; ld16_sc1x3(p, p + 3072, p + 6144, o0, o1, o2);
            const float l0 = lseL[tl], l1 = lseL[512 + tl], l2 = lseL[1024 + tl];
            const float mx = fmaxf(l0, fmaxf(l1, l2));
            float w0 = __builtin_amdgcn_exp2f(l0 - mx), w1 = __builtin_amdgcn_exp2f(l1 - mx), w2 = __builtin_amdgcn_exp2f(l2 - mx);
            const float inv = __builtin_amdgcn_rcpf(w0 + w1 + w2); w0 *= inv; w1 *= inv; w2 *= inv;
            u32x4 res;
#pragma unroll
            for (int k = 0; k < 4; ++k) { const float lo = w0 * bflo(o0[k]) + w1 * bflo(o1[k]) + w2 * bflo(o2[k]), hh = w0 * bfhi(o0[k]) + w1 * bfhi(o1[k]) + w2 * bfhi(o2[k]); res[k] = cvtpk(lo, hh); }
            *(u32x4*)(Oh + tok * DM + h * 64 + ch * 8) = res;
        }
    }
    __syncthreads();
}

constexpr int NWAVES = 8;
#ifndef ONLY_TYPE
#define PH_ON(t) true
#else
#define PH_ON(t) ((t) == ONLY_TYPE)
#endif
enum { T_PRO = 0, T_CIN, T_CONV, T_COUT, T_QKV, T_ATT, T_WO, T_ROUTE, T_MOE1, T_MOE2, T_NORM };

typedef const __attribute__((address_space(4))) Args* KArgs;
__global__ void __launch_bounds__(NWAVES * 64, 2) hybrid_fwd(Args args_unused) {
    extern __shared__ __attribute__((aligned(16))) unsigned char lds_raw[];
    LAS unsigned char* lds = (LAS unsigned char*)lds_raw;
    volatile LAS unsigned* MISC = (volatile LAS unsigned*)(lds + MISC_OFF);
    LAS int* mtbl = (LAS int*)(lds + LDSCTL_OFF);
    KArgs ap0 = (KArgs)__builtin_amdgcn_kernarg_segment_ptr();
    const int G = gridDim.x; const int bx = blockIdx.x; const int vcu = (G % 8 == 0) ? (bx % 8) * (G / 8) + bx / 8 : bx;
    for (int u = threadIdx.x; u < (LDS_BYTES - LDSCTL_OFF) / 4; u += NWAVES * 64) ((LAS unsigned*)(lds + LDSCTL_OFF))[u] = 0u;
    __syncthreads();
    XcdBarrier bar; bar.bar = (unsigned*)((gu32*)(ap0->ws + WS_CTL) + CW_BAR); bar.x = 0; bar.st = nullptr;
    if (MK_N_LAUNCHES == 1) bar = xcd_barrier_post(bar.bar, MISC + 8);
    const int ph_lo = ap0->ph_lo, ph_hi = ap0->ph_hi;

    for (int ph = ph_lo; ph < ph_hi; ++ph) {
        int tid = threadIdx.x; asm volatile("" : "+v"(tid));
        KArgs ap = ap0; asm volatile("" : "+s"(ap));
        const int lane = tid & 63, wave = __builtin_amdgcn_readfirstlane(tid >> 6);
        const int gw_id = vcu * NWAVES + wave, NGW = G * NWAVES;
        unsigned char* ws = ap->ws;
        gu32* ctl = (gu32*)(ws + WS_CTL);
        bf16_t* WCIN = (bf16_t*)(ws + WS_WCIN); bf16_t* WCOUT = (bf16_t*)(ws + WS_WCOUT); bf16_t* WQKV = (bf16_t*)(ws + WS_WQKV); bf16_t* WO = (bf16_t*)(ws + WS_WO);
        bf16_t* WGU = (bf16_t*)(ws + WS_WGU); bf16_t* WDN = (bf16_t*)(ws + WS_WDN); bf16_t* HN = (bf16_t*)(ws + WS_HN);
        unsigned char* R = ws + WS_R;
        int* list = (int*)(ws + WS_LIST); float* gate = (float*)(ws + WS_GATE);
        _Float16* cosT = (_Float16*)(ws + WS_COS); _Float16* sinT = (_Float16*)(ws + WS_SIN);
        int type, L = 0, half = 0;
        if (ph == 0) type = T_PRO;
        else { int p = ph - 1, sub; bool conv;
            if (p < 7) { L = 0; sub = p; conv = true; } else if (p < 16) { L = 1; sub = p - 7; conv = false; } else if (p < 23) { L = 2; sub = p - 16; conv = true; } else { L = 3; sub = p - 23; conv = false; }
            if (conv) { const int tt[7] = {T_CIN, T_CONV, T_COUT, T_ROUTE, T_MOE1, T_MOE2, T_NORM}; type = sub == 0 ? T_CIN : sub == 1 ? T_CONV : sub == 2 ? T_COUT : sub == 3 ? T_ROUTE : sub == 4 ? T_MOE1 : sub == 5 ? T_MOE2 : T_NORM; (void)tt; }
            else { type = sub == 0 ? T_QKV : sub == 1 ? T_ATT : sub == 2 ? T_QKV : sub == 3 ? T_ATT : sub == 4 ? T_WO : sub == 5 ? T_ROUTE : sub == 6 ? T_MOE1 : sub == 7 ? T_MOE2 : T_NORM; half = (sub >= 2) ? 1 : 0; } }
        const int j2 = L >> 1;
        switch (type) {
        case T_PRO: if (PH_ON(T_PRO)) {
            LAS float* scr = (LAS float*)(lds + wave * 16640);
            constexpr int I0 = 2 * 16 * 48, I1 = 2 * 16 * 16, I2 = 2 * 16 * 144, I3 = 2 * 16 * 16, I4 = 64 * 16 * 8, I5 = 64 * 16 * 8, I6 = 64 * 8 * 16;
            constexpr int NITEMS = I0 + I1 + I2 + I3 + I4 + I5 + I6;
            for (int it = gw_id; it < NITEMS; it += NGW) {
                int r = it;
                if (r < I0) { const int mat = r / (16 * 48), item = r % (16 * 48); transpose_item(ap->conv_w_in + (size_t)mat * 1024 * 3072, 1024, 3072, WCIN + (size_t)mat * 3072 * 1024, 1, scr, item, lane); continue; } r -= I0;
                if (r < I1) { const int mat = r / 256, item = r % 256; transpose_item(ap->conv_w_out + (size_t)mat * 1048576, 1024, 1024, WCOUT + (size_t)mat * 1048576, 0, scr, item, lane); continue; } r -= I1;
                if (r < I2) { const int mat = r / (16 * 144), item = r % (16 * 144); transpose_item(ap->attn_w_qkv + (size_t)mat * 1024 * 9216, 1024, 9216, WQKV + (size_t)mat * 9216 * 1024, 2, scr, item, lane); continue; } r -= I2;
                if (r < I3) { const int mat = r / 256, item = r % 256; transpose_item(ap->attn_w_o + (size_t)mat * 1048576, 1024, 1024, WO + (size_t)mat * 1048576, 0, scr, item, lane); continue; } r -= I3;
                if (r < I4) { const int mat = r / 128, item = r % 128; transpose_item(ap->w_gate + (size_t)mat * 524288, 1024, 512, WGU + (size_t)mat * 1048576, 3, scr, item, lane); continue; } r -= I4;
                if (r < I5) { const int mat = r / 128, item = r % 128; transpose_item(ap->w_up + (size_t)mat * 524288, 1024, 512, WGU + (size_t)mat * 1048576, 4, scr, item, lane); continue; } r -= I5;
                { const int mat = r / 128, item = r % 128; transpose_item(ap->w_down + (size_t)mat * 524288, 512, 1024, WDN + (size_t)mat * 524288, 0, scr, item, lane); }
            }
            for (int idx = (vcu * 512 + tid); idx < NTOK * 32; idx += G * 512) { const int tok = idx >> 5, i = idx & 31;
                const double rev = (double)ap->pos[tok] * INVREV[i]; const float fr = (float)(rev - floor(rev));
                cosT[idx] = (_Float16)__builtin_amdgcn_cosf(fr); sinT[idx] = (_Float16)__builtin_amdgcn_sinf(fr); }
            norm_rows<0>(ap->x, nullptr, nullptr, ap->norm_mix, HN, gw_id, lane);
        } break;
        case T_CIN: if (PH_ON(T_CIN)) {
            pg8::Gemm g{HN, WCIN + (size_t)j2 * 3072 * 1024, 1024}; pg8::DenseOrder S; S.init(NTOK, 3072, G, bx);
            pg8::EpiConvIn E{(bf16_t*)(R + R_BG), (bf16_t*)(R + R_U)};
            pg8::gemm_phase<pg8::EpiConvIn, pg8::DenseOrder, false, true>(lds, g, S, E, tid);
        } break;
        case T_CONV: if (PH_ON(T_CONV)) {
            conv_phase((const bf16_t*)(R + R_BG), (const bf16_t*)(R + R_U), (bf16_t*)(R + R_Y), ap->conv_w + (size_t)j2 * 3072, gw_id, lane);
        } break;
        case T_COUT: case T_WO: if (PH_ON(T_COUT)) {
            const bf16_t* A = (type == T_COUT) ? (const bf16_t*)(R + R_Y) : HN;
            const bf16_t* Bt = (type == T_COUT) ? WCOUT + (size_t)j2 * 1048576 : WO + (size_t)j2 * 1048576;
            pg8::Gemm g{A, Bt, 1024}; pg8::DenseOrder S; S.init(NTOK, 1024, G, bx);
            pg8::EpiRes E{(L == 0) ? ap->x : ap->out, ap->out};
            pg8::gemm_phase<pg8::EpiRes, pg8::DenseOrder, false, true>(lds, g, S, E, tid);
        } break;
        case T_QKV: if (PH_ON(T_QKV)) {
            pg8::Gemm g{HN + (size_t)half * HTOK * DM, WQKV + (size_t)j2 * 9216 * 1024, 1024}; pg8::DenseOrder S; S.init(HTOK, QKVW, G, bx);
            pg8::EpiQKV E{(bf16_t*)R, cosT, sinT, half * HTOK};
            pg8::gemm_phase<pg8::EpiQKV, pg8::DenseOrder, false, true>(lds, g, S, E, tid);
        } break;
        case T_ATT: if (PH_ON(T_ATT)) {
            attn_phase(lds, (bf16_t*)R, HN + (size_t)half * HTOK * DM, vcu, wave, lane);
        } break;
        case T_ROUTE: if (PH_ON(T_ROUTE)) {
            route_phase(lds, ap->out, ap->norm_ffn + L * DM, HN, ap->w_coarse + (size_t)L * 4096, ap->b_coarse + L * 4, ap->w_fine + (size_t)L * 16384, ap->b_fine + L * 16,
                        (unsigned*)(ctl + CW_CNT + 64 * L), list, gate, gw_id, wave, lane, tid);
        } break;
        case T_MOE1: case T_MOE2: if (PH_ON(T_MOE1)) {
            if (tid == 0) { int us = 0, hr = 0;
                for (int e = 0; e < 16; ++e) { const int c = (int)__hip_atomic_load(ctl + CW_CNT + 64 * L + e, RLX_AGENT); const int tiles = (c + 255) >> 8;
                    mtbl[e] = us; mtbl[32 + e] = hr; mtbl[64 + e] = c; us += tiles * 4; hr += tiles * 256; }
                mtbl[16] = us; }
            __syncthreads();
            pg8::MoeOrder S{mtbl, G, bx, list, 0};
            if (type == T_MOE1) {
                pg8::Gemm g{HN, WGU + (size_t)L * 16 * 1048576, 1024};
                pg8::EpiMoeGU E{(bf16_t*)(R + R_H)};
                pg8::gemm_phase<pg8::EpiMoeGU, pg8::MoeOrder, true, true>(lds, g, S, E, tid);
            } else {
                pg8::Gemm g{(const bf16_t*)(R + R_H), WDN + (size_t)L * 16 * 524288, 512};
                pg8::EpiMoeDown E{(bf16_t*)(R + R_YS), list, gate};
                pg8::gemm_phase<pg8::EpiMoeDown, pg8::MoeOrder, false, true>(lds, g, S, E, tid);
            }
        } break;
        case T_NORM: if (PH_ON(T_NORM)) {
            if (L == DEPTH - 1) norm_rows<2>(ap->out, ap->out, (const bf16_t*)(R + R_YS), ap->norm_final, HN, gw_id, lane);
            else norm_rows<1>(ap->out, ap->out, (const bf16_t*)(R + R_YS), ap->norm_mix + (L + 1) * DM, HN, gw_id, lane);
        } break;
        }
        if (ph + 1 < ph_hi) xcd_barrier(bar);
    }
}

extern "C" void kernel_launch(void* const* d_in, const int* in_sizes, int n_in, void* d_out, int out_size, void* d_ws, size_t ws_size, hipStream_t stream) {
    static int grid = 0;
    if (grid == 0) {
        if (n_in != 17 || in_sizes[0] != NTOK * DM || out_size != NTOK * DM || ws_size < WS_END) { fprintf(stderr, "kernel_launch: unexpected shapes/workspace (n_in %d, in0 %d, out %d, ws %zu < %zu)\n", n_in, n_in > 0 ? in_sizes[0] : -1, out_size, ws_size, (size_t)WS_END); grid = -1; return; }
        int dev = 0, cus = 0;
        if (hipGetDevice(&dev) != hipSuccess || hipDeviceGetAttribute(&cus, hipDeviceAttributeMultiprocessorCount, dev) != hipSuccess) { grid = -1; return; }
        if (hipFuncSetAttribute((const void*)hybrid_fwd, hipFuncAttributeMaxDynamicSharedMemorySize, LDS_BYTES) != hipSuccess) { fprintf(stderr, "kernel_launch: hipFuncSetAttribute failed\n"); grid = -1; return; }
        (void)hipGetLastError();
        grid = cus;
        if (grid != 256) fprintf(stderr, "kernel_launch: %d CUs (built for 256)\n", grid);
    }
    if (grid < 0) return;
    (void)hipMemsetAsync((char*)d_ws + WS_CTL, 0, CTL_ZERO_BYTES, stream);
    Args a{};
    a.x = (const float*)d_in[0]; a.pos = (const int*)d_in[1]; a.norm_mix = (const float*)d_in[2]; a.norm_ffn = (const float*)d_in[3]; a.norm_final = (const float*)d_in[4];
    a.conv_w_in = (const float*)d_in[5]; a.conv_w = (const float*)d_in[6]; a.conv_w_out = (const float*)d_in[7]; a.attn_w_qkv = (const float*)d_in[8]; a.attn_w_o = (const float*)d_in[9];
    a.w_coarse = (const float*)d_in[10]; a.b_coarse = (const float*)d_in[11]; a.w_fine = (const float*)d_in[12]; a.b_fine = (const float*)d_in[13];
    a.w_gate = (const float*)d_in[14]; a.w_up = (const float*)d_in[15]; a.w_down = (const float*)d_in[16];
    a.out = (float*)d_out; a.ws = (unsigned char*)d_ws;
    if (MK_N_LAUNCHES == 1) { a.ph_lo = 0; a.ph_hi = NPHASE; hipLaunchKernelGGL(hybrid_fwd, dim3(grid), dim3(NWAVES * 64), LDS_BYTES, stream, a); }
    else { for (int p = 0; p < NPHASE; ++p) { a.ph_lo = p; a.ph_hi = p + 1; hipLaunchKernelGGL(hybrid_fwd, dim3(grid), dim3(NWAVES * 64), LDS_BYTES, stream, a); } }
}
```

```cpp
#include <hip/hip_runtime.h>
#include <hip/hip_fp16.h>
#include <cstdio>
#include <cstdint>

#define LAS __attribute__((address_space(3)))
#define GAS __attribute__((address_space(1)))
typedef unsigned short bf16_t;
typedef short bf16x8 __attribute__((ext_vector_type(8)));
typedef short s16x4 __attribute__((ext_vector_type(4)));
typedef float f32x2 __attribute__((ext_vector_type(2)));
typedef float f32x4 __attribute__((ext_vector_type(4)));
typedef float f32x16 __attribute__((ext_vector_type(16)));
typedef unsigned u32x2 __attribute__((ext_vector_type(2)));
typedef unsigned u32x4 __attribute__((ext_vector_type(4)));
typedef __bf16 bf16x2_t __attribute__((ext_vector_type(2)));
typedef _Float16 h16x8 __attribute__((ext_vector_type(8)));

#ifndef PROBE
#define PROBE 0
#endif
#ifndef PROBE_VM
#define PROBE_VM 0x1ull
#endif
#ifndef PROBE_WM
#define PROBE_WM 0x0ull
#endif
#ifndef PROBE_W_WORK
#define PROBE_W_WORK 0
#endif
#ifndef DUP_TYPE
#define DUP_TYPE -1
#endif
#ifndef EPI_EXP
#define EPI_EXP 0
#endif
#ifndef MK_N_LAUNCHES
#define MK_N_LAUNCHES 1
#endif

constexpr int NTOK = 32768, DM = 1024, SEQ = 4096, DEPTH = 4;
constexpr int HTOK = 16384;
constexpr int QKVW = 9216;
constexpr int TSZ = 16384 * 256;
constexpr int QP = 256;
constexpr float EPS = 1e-6f;
constexpr float LOG2E = 1.4426950408889634f;
constexpr float C2 = 0.125f * LOG2E;
constexpr int NPHASE = 37;
constexpr int HP = 1024;

constexpr size_t MiB = 1u << 20;
constexpr size_t WS_CTL = 0, CTL_ZERO_BYTES = 32768;
constexpr size_t WS_LIST = 1 * MiB;
constexpr size_t WS_GATE = 3 * MiB;
constexpr size_t WS_LSE = 5 * MiB;
constexpr size_t WS_COS = 5 * MiB;
constexpr size_t WS_SIN = 7 * MiB;
constexpr size_t WS_RSC = 7 * MiB;
constexpr size_t WS_WCIN = 9 * MiB;
constexpr size_t WS_WCOUT = 21 * MiB;
constexpr size_t WS_WQKV = 25 * MiB;
constexpr size_t WS_WO = 61 * MiB;
constexpr size_t WS_WGU = 65 * MiB;
constexpr size_t WS_WDN = 193 * MiB;
constexpr size_t WS_HN = 257 * MiB;
constexpr size_t WS_R = 321 * MiB;
constexpr size_t WS_END = 609 * MiB;
constexpr size_t R_BG = 0, R_U = 64 * MiB, R_Y = 128 * MiB, R_D = 0;
constexpr size_t R_H3 = 202 * MiB;
constexpr size_t R_H = 0, R_YS = 72 * MiB;
constexpr int CW_CNT = 1024;
constexpr int CW_BAR = 4096;

constexpr int RING_BYTES = 147456;
constexpr int LDSCTL_OFF = RING_BYTES, MISC_OFF = LDSCTL_OFF + 1024;
constexpr int LDS_BYTES = 155648;

__device__ __forceinline__ unsigned cvtpk(float lo, float hi) { f32x2 v = {lo, hi}; bf16x2_t b = __builtin_convertvector(v, bf16x2_t); return __builtin_bit_cast(unsigned, b); }
__device__ __forceinline__ float bflo(unsigned u) { return __uint_as_float(u << 16); }
__device__ __forceinline__ float bfhi(unsigned u) { return __uint_as_float(u & 0xffff0000u); }
__device__ __forceinline__ float dpp_xadd(float v, const int ctrl) { return v; }
#define DPP_ADD(v, ctrl) (v) += __int_as_float(__builtin_amdgcn_update_dpp(0, __float_as_int(v), (ctrl), 0xF, 0xF, true))
__device__ __forceinline__ float wave_sum(float v) {
    DPP_ADD(v, 0xB1);
    DPP_ADD(v, 0x4E);
    DPP_ADD(v, 0x141);
    DPP_ADD(v, 0x140);
    { auto r = __builtin_amdgcn_permlane16_swap(__float_as_uint(v), __float_as_uint(v), false, false); v = __uint_as_float(r[0]) + __uint_as_float(r[1]); }
    { auto r = __builtin_amdgcn_permlane32_swap(__float_as_uint(v), __float_as_uint(v), false, false); v = __uint_as_float(r[0]) + __uint_as_float(r[1]); }
    return v;
}
#define LDS_WAIT() asm volatile("s_waitcnt lgkmcnt(0)" ::: "memory")
#define VM_WAIT() asm volatile("s_waitcnt vmcnt(0)" ::: "memory")

namespace pg8 {
constexpr int BM = 256, BK = 64, HALF = 128, HTB = HALF * BK * 2, STAGE_BYTES = 8 * HTB, NXCD = 8, WGM = 8;
__host__ __device__ __forceinline__ int lds_byte(int r, int c) { const int st = (r >> 4) * 2 + (c >> 5), rr = r & 15, cc = c & 31, ob = rr * 64 + cc * 2; return st * 1024 + (ob ^ (((ob >> 9) & 1) << 5)); }
__host__ __device__ __forceinline__ void stage_rc(int b, int& R, int& C) { const int st = b / 1024, sb = b % 1024, swz = sb ^ (((sb >> 9) & 1) << 5); R = (st >> 1) * 16 + swz / 64; C = (st & 1) * 32 + (swz % 64) / 2; }
__host__ __device__ __forceinline__ int perm32(int rho) { const int n = rho >> 4, i = rho & 15; return 8 * (i >> 2) + 4 * n + (i & 3); }

struct Unit { int pm, pn, arow, brow, x0, x1; };
struct Gemm { const bf16_t* A; const bf16_t* Bt; int K; };

struct DenseOrder {
    static constexpr bool TAIL = false;
    int nM, nN, nwg, G, c;
    __device__ void init(int M, int N, int G_, int c_) { nM = M / BM; nN = N / BM; nwg = nM * nN; G = G_; c = c_; }
    __device__ bool next(int i, Unit& u) const {
        const long L = (long)i * G + c; if (L >= nwg) return false;
        int wgid = (int)L; { const int q = nwg / NXCD, r = nwg % NXCD, xcd = wgid % NXCD, off = wgid / NXCD; wgid = (xcd < r ? xcd * (q + 1) : r * (q + 1) + (xcd - r) * q) + off; }
        const int nig = WGM * nN, gid = wgid / nig, fm = gid * WGM, gsz = (nM - fm) < WGM ? (nM - fm) : WGM;
        u.pm = fm + ((wgid % nig) % gsz); u.pn = (wgid % nig) / gsz; u.arow = u.pm * BM; u.brow = u.pn * BM; u.x0 = 0; u.x1 = 0; return true;
    }
    __device__ __forceinline__ unsigned arow_of(const Unit&, int) const { return 0u; }
};
struct MoeOrder {
    static constexpr bool TAIL = true;
    const LAS int* tbl; int G, c; const int* list;
    __device__ bool next(int i, Unit& u) const {
        const int L = i * G + c; const int nfull = __builtin_amdgcn_readfirstlane(tbl[16]), total = nfull + __builtin_amdgcn_readfirstlane(tbl[36]); if (L >= total) return false;
        int e = 0, Le, mt, pn;
        if (L < nfull) {
            int wgid = L; { const int q = nfull / NXCD, r = nfull % NXCD, xcd = wgid % NXCD, off = wgid / NXCD; wgid = (xcd < r ? xcd * (q + 1) : r * (q + 1) + (xcd - r) * q) + off; }
#pragma unroll
            for (int k = 1; k < 16; ++k) { const int s = __builtin_amdgcn_readfirstlane(tbl[k]); if (wgid >= s) e = k; }
            Le = wgid - __builtin_amdgcn_readfirstlane(tbl[e]); mt = Le >> 2; pn = Le & 3;
        } else {
            const int Lt = L - nfull;
#pragma unroll
            for (int k = 1; k < 16; ++k) { const int s = __builtin_amdgcn_readfirstlane(tbl[20 + k]); if (Lt >= s) e = k; }
            pn = Lt - __builtin_amdgcn_readfirstlane(tbl[20 + e]); mt = __builtin_amdgcn_readfirstlane(tbl[60 + e]) >> 8;
        }
        u.pm = mt; u.pn = pn; u.x0 = e; u.x1 = __builtin_amdgcn_readfirstlane(tbl[60 + e]);
        u.arow = __builtin_amdgcn_readfirstlane(tbl[40 + e]) + mt * BM; u.brow = e * 1024 + pn * BM; return true;
    }
    __device__ __forceinline__ unsigned arow_of(const Unit& u, int r) const { const int pos = u.pm * BM + r; return pos < u.x1 ? (unsigned)(list[u.x0 * 32768 + pos] >> 1) : 0u; }
};

struct EpiConvIn {
    static constexpr bool PERM = true;
    bf16_t* Bg; bf16_t* U;
    __device__ __forceinline__ int nst(const Unit& u) const { return u.pn < 4 ? 16 : 8; }
    __device__ __forceinline__ void operator()(const f32x4 (&acc)[2][2][4][2], const Unit& u, int wr, int wc, int fr, int fq) const {
        const int row0 = u.pm * BM + wr * 64 + fr;
        if (u.pn < 4) {
            const int col0 = u.pn * BM + wc * 32 + 8 * fq;
#pragma unroll
            for (int ai = 0; ai < 2; ++ai)
#pragma unroll
                for (int m = 0; m < 4; ++m) { bf16_t* rowp = Bg + (size_t)(row0 + ai * HALF + m * 16) * DM + col0;
#pragma unroll
                    for (int bj = 0; bj < 2; ++bj) { const f32x4 v0 = acc[ai][bj][m][0], v1 = acc[ai][bj][m][1]; u32x4 w; w.x = cvtpk(v0[0], v0[1]); w.y = cvtpk(v0[2], v0[3]); w.z = cvtpk(v1[0], v1[1]); w.w = cvtpk(v1[2], v1[3]);
                        *(u32x4*)(rowp + bj * HALF) = w; } }
        } else {
            const int col0 = (u.pn - 4) * HALF + wc * 32 + 8 * fq;
#pragma unroll
            for (int ai = 0; ai < 2; ++ai)
#pragma unroll
                for (int m = 0; m < 4; ++m) { bf16_t* rowp = U + (size_t)(row0 + ai * HALF + m * 16) * DM + col0;
                    const f32x4 v0 = acc[ai][0][m][0] * acc[ai][1][m][0], v1 = acc[ai][0][m][1] * acc[ai][1][m][1]; u32x4 w; w.x = cvtpk(v0[0], v0[1]); w.y = cvtpk(v0[2], v0[3]); w.z = cvtpk(v1[0], v1[1]); w.w = cvtpk(v1[2], v1[3]);
                    *(u32x2*)rowp = (u32x2){w.x, w.y}; *(u32x2*)(rowp + 4) = (u32x2){w.z, w.w}; }
        }
    }
};
struct EpiDelta {
    static constexpr bool PERM = true;
    bf16_t* D;
    __device__ __forceinline__ int nst(const Unit&) const { return 16; }
    __device__ __forceinline__ void operator()(const f32x4 (&acc)[2][2][4][2], const Unit& u, int wr, int wc, int fr, int fq) const {
        const int row0 = u.pm * BM + wr * 64 + fr, col0 = u.pn * BM + wc * 32 + 8 * fq;
#pragma unroll
        for (int ai = 0; ai < 2; ++ai)
#pragma unroll
            for (int m = 0; m < 4; ++m) { bf16_t* rowp = D + (size_t)(row0 + ai * HALF + m * 16) * DM + col0;
#pragma unroll
                for (int bj = 0; bj < 2; ++bj) { const f32x4 v0 = acc[ai][bj][m][0], v1 = acc[ai][bj][m][1]; u32x4 w; w.x = cvtpk(v0[0], v0[1]); w.y = cvtpk(v0[2], v0[3]); w.z = cvtpk(v1[0], v1[1]); w.w = cvtpk(v1[2], v1[3]);
                    *(u32x4*)(rowp + bj * HALF) = w; } }
    }
};
struct EpiResB {
    static constexpr bool PERM = true;
    const float* xf; const bf16_t* hin; bf16_t* h;
    __device__ __forceinline__ int nst(const Unit&) const { return 16; }
    __device__ __forceinline__ void operator()(const f32x4 (&acc)[2][2][4][2], const Unit& u, int wr, int wc, int fr, int fq) const {
        const int row0 = u.pm * BM + wr * 64 + fr, col0 = u.pn * BM + wc * 32 + 8 * fq;
#pragma unroll
        for (int ai = 0; ai < 2; ++ai)
#pragma unroll
            for (int m = 0; m < 4; ++m) { const int row = row0 + ai * HALF + m * 16; bf16_t* rowp = h + (size_t)row * HP + col0;
                f32x4 b[2][2];
                if (xf) {
#pragma unroll
                    for (int bj = 0; bj < 2; ++bj) { b[bj][0] = *(const f32x4*)(xf + (size_t)row * DM + col0 + bj * HALF); b[bj][1] = *(const f32x4*)(xf + (size_t)row * DM + col0 + bj * HALF + 4); }
                } else {
#pragma unroll
                    for (int bj = 0; bj < 2; ++bj) { const u32x4 t = *(const u32x4*)(hin + (size_t)row * HP + col0 + bj * HALF); b[bj][0] = (f32x4){bflo(t.x), bfhi(t.x), bflo(t.y), bfhi(t.y)}; b[bj][1] = (f32x4){bflo(t.z), bfhi(t.z), bflo(t.w), bfhi(t.w)}; }
                }
#pragma unroll
                for (int bj = 0; bj < 2; ++bj) { const f32x4 v0 = acc[ai][bj][m][0] + b[bj][0], v1 = acc[ai][bj][m][1] + b[bj][1]; u32x4 w; w.x = cvtpk(v0[0], v0[1]); w.y = cvtpk(v0[2], v0[3]); w.z = cvtpk(v1[0], v1[1]); w.w = cvtpk(v1[2], v1[3]);
                    *(u32x4*)(rowp + bj * HALF) = w; }
                if (m & 1) asm volatile("" ::: "memory"); }
    }
};
struct EpiRes {
    static constexpr bool PERM = false;
    const float* base; float* out;
    __device__ __forceinline__ int nst(const Unit&) const { return 16; }
    __device__ __forceinline__ void operator()(const f32x4 (&acc)[2][2][4][2], const Unit& u, int wr, int wc, int fr, int fq) const {
        const int col0 = u.pn * BM + wc * 32 + 4 * fq;
#pragma unroll
        for (int ai = 0; ai < 2; ++ai)
#pragma unroll
            for (int m = 0; m < 4; ++m) { const size_t off = (size_t)(u.pm * BM + ai * HALF + wr * 64 + m * 16 + fr) * DM + col0;
                f32x4 b[2][2];
#pragma unroll
                for (int bj = 0; bj < 2; ++bj)
#pragma unroll
                    for (int n = 0; n < 2; ++n) b[bj][n] = *(const f32x4*)(base + off + bj * HALF + n * 16);
#pragma unroll
                for (int bj = 0; bj < 2; ++bj)
#pragma unroll
                    for (int n = 0; n < 2; ++n) *(f32x4*)(out + off + bj * HALF + n * 16) = b[bj][n] + acc[ai][bj][m][n];
                if (m & 1) asm volatile("" ::: "memory"); }
    }
};
struct EpiQKV {
    static constexpr bool PERM = true;
    bf16_t* O; const int* pos; int tok0;
    __device__ __forceinline__ int nst(const Unit&) const { return 16; }
    __device__ __forceinline__ void operator()(const f32x4 (&acc)[2][2][4][2], const Unit& u, int wr, int wc, int fr, int fq) const {
        const int sec = u.pn >> 2, kind = sec % 3, head = (u.pn & 3) * 4 + wc;
        const int col = sec * 1024 + head * 64 + 8 * fq;
        const int rbase = u.pm * BM + wr * 64 + fr;
        float pf[2][4];
        float ir[8];
        if (kind < 2) {
#pragma unroll
            for (int ai = 0; ai < 2; ++ai)
#pragma unroll
                for (int m = 0; m < 4; ++m) pf[ai][m] = (float)pos[tok0 + rbase + ai * HALF + m * 16];
#pragma unroll
            for (int i = 0; i < 8; ++i) ir[i] = __builtin_amdgcn_exp2f(-(float)(8 * fq + i) * 0.41524101186092029f) * 0.15915494309189535f;
        }
#pragma unroll
        for (int ai = 0; ai < 2; ++ai)
#pragma unroll
            for (int m = 0; m < 4; ++m) { const int rloc = rbase + ai * HALF + m * 16;
                bf16_t* rowp = O + ((size_t)u.pn * TSZ + (size_t)rloc * QP + wc * 64 + 8 * fq); (void)col;
                f32x4 a0 = acc[ai][0][m][0], a1 = acc[ai][0][m][1], b0 = acc[ai][1][m][0], b1 = acc[ai][1][m][1];
                if (kind < 2) {
                    const float sc = kind == 0 ? C2 : 1.f;
#pragma unroll
                    for (int i = 0; i < 4; ++i) {
                        const float f0 = __builtin_amdgcn_fractf(pf[ai][m] * ir[i]), f1 = __builtin_amdgcn_fractf(pf[ai][m] * ir[4 + i]);
                        const float c0 = __builtin_amdgcn_cosf(f0) * sc, s0 = __builtin_amdgcn_sinf(f0) * sc, c1 = __builtin_amdgcn_cosf(f1) * sc, s1 = __builtin_amdgcn_sinf(f1) * sc;
                        const float x1 = a0[i], x2 = b0[i], y1 = a1[i], y2 = b1[i];
                        a0[i] = x1 * c0 - x2 * s0; b0[i] = x2 * c0 + x1 * s0; a1[i] = y1 * c1 - y2 * s1; b1[i] = y2 * c1 + y1 * s1; }
                }
                u32x4 w; w.x = cvtpk(a0[0], a0[1]); w.y = cvtpk(a0[2], a0[3]); w.z = cvtpk(a1[0], a1[1]); w.w = cvtpk(a1[2], a1[3]); *(u32x4*)rowp = w;
                w.x = cvtpk(b0[0], b0[1]); w.y = cvtpk(b0[2], b0[3]); w.z = cvtpk(b1[0], b1[1]); w.w = cvtpk(b1[2], b1[3]); *(u32x4*)(rowp + 32) = w; }
    }
};
struct EpiMoeGU {
    static constexpr bool PERM = true;
    bf16_t* H; const float* rsc;
    __device__ __forceinline__ int nst(const Unit&) const { return 8; }
    __device__ __forceinline__ void operator()(const f32x4 (&acc)[2][2][4][2], const Unit& u, int wr, int wc, int fr, int fq) const {
        const int col0 = u.pn * HALF + wc * 32 + 8 * fq;
        float rs[2][4];
#pragma unroll
        for (int ai = 0; ai < 2; ++ai)
#pragma unroll
            for (int m = 0; m < 4; ++m) { const int pos = u.pm * BM + ai * HALF + wr * 64 + m * 16 + fr; rs[ai][m] = pos < u.x1 ? rsc[u.x0 * 32768 + pos] : 0.f; }
#pragma unroll
        for (int ai = 0; ai < 2; ++ai)
#pragma unroll
            for (int m = 0; m < 4; ++m) { bf16_t* rowp = H + (size_t)(u.arow + ai * HALF + wr * 64 + m * 16 + fr) * 512 + col0;
                float o[8];
#pragma unroll
                for (int n = 0; n < 2; ++n)
#pragma unroll
                    for (int i = 0; i < 4; ++i) { const float gt = acc[ai][0][m][n][i] * rs[ai][m], up = acc[ai][1][m][n][i] * rs[ai][m];
                        o[n * 4 + i] = gt * __builtin_amdgcn_rcpf(1.f + __builtin_amdgcn_exp2f(-gt * LOG2E)) * up; }
                u32x4 w; w.x = cvtpk(o[0], o[1]); w.y = cvtpk(o[2], o[3]); w.z = cvtpk(o[4], o[5]); w.w = cvtpk(o[6], o[7]); *(u32x2*)rowp = (u32x2){w.x, w.y}; *(u32x2*)(rowp + 4) = (u32x2){w.z, w.w}; }
    }
};
struct EpiMoeDown {
    static constexpr bool PERM = true;
    bf16_t* YS; const int* list; const float* gate;
    __device__ __forceinline__ int nst(const Unit& u) const { return (u.x1 - u.pm * BM >= BM) ? 16 : 0; }
    __device__ __forceinline__ void operator()(const f32x4 (&acc)[2][2][4][2], const Unit& u, int wr, int wc, int fr, int fq) const {
        const int col0 = u.pn * BM + wc * 32 + 8 * fq;
#pragma unroll
        for (int ai = 0; ai < 2; ++ai)
#pragma unroll
            for (int m = 0; m < 4; ++m) { const int pos = u.pm * BM + ai * HALF + wr * 64 + m * 16 + fr;
                { const bool ok = pos < u.x1; const int dst = ok ? list[u.x0 * 32768 + pos] : 65536  ; const float gw = ok ? gate[u.x0 * 32768 + pos] : 0.f;
                    bf16_t* rowp = YS + (size_t)dst * DM + col0;
#pragma unroll
                    for (int bj = 0; bj < 2; ++bj) { const f32x4 v0 = acc[ai][bj][m][0] * gw, v1 = acc[ai][bj][m][1] * gw; u32x4 w; w.x = cvtpk(v0[0], v0[1]); w.y = cvtpk(v0[2], v0[3]); w.z = cvtpk(v1[0], v1[1]); w.w = cvtpk(v1[2], v1[3]);
                        *(u32x4*)(rowp + bj * HALF) = w; } } }
    }
};

template <class Epi, class Sched, bool GATHER, bool ALIGN_EPI>
__device__ __forceinline__ void gemm_phase(LAS unsigned char* lds, const Gemm g, const Sched& S, const Epi& E, const int tid) {
    const int wid = __builtin_amdgcn_readfirstlane(tid >> 6), lane = tid & 63, wr = wid >> 2, wc = wid & 3, fr = lane & 15, fq = lane >> 4;
    const int K = g.K, nt = K / BK;
    unsigned voffA[2], voffB[2]; int RA[2]; unsigned CA2[2];
#pragma unroll
    for (int i = 0; i < 2; ++i) { int R, C; stage_rc(tid * 16 + i * 8192, R, C); const int Rb = Epi::PERM ? ((R & ~31) + perm32(R & 31)) : R;
        voffA[i] = (unsigned)(R * K + C) * 2u; voffB[i] = (unsigned)(Rb * K + C) * 2u; RA[i] = R; CA2[i] = (unsigned)C * 2u; }
    const size_t kstep = (size_t)(BK * 2);
    const size_t hstep = (size_t)HALF * K * 2;
    const size_t hstepA = GATHER ? (size_t)0 : hstep;
    const unsigned ldsw = (unsigned)wid * 1024u;
    const int aoff = lds_byte(wr * 64 + fr, fq * 8), boff = lds_byte(wc * 32 + fr, fq * 8);
#define PG8_SA(b, h) (((b) * 2 + (h)) * HTB)
#define PG8_SB(b, h) ((4 + (b) * 2 + (h)) * HTB)
#define PG8_STAGE(bufoff, gbase, voff) do { _Pragma("unroll") for (int _i = 0; _i < 2; ++_i) \
        __builtin_amdgcn_global_load_lds((const unsigned*)((const char*)(gbase) + (voff)[_i]), (LAS unsigned*)(lds + (bufoff) + ldsw + _i * 8192), 16, 0, 0); } while (0)
#define PG8_STAGE_A0(bufoff, ptr, V0) PG8_STAGE(bufoff, ptr, V0)
#define PG8_STAGE_A1(bufoff, ptr, V1) PG8_STAGE(bufoff, (ptr) + hstepA, V1)
#define PG8_LDA(dst, b, h) do { _Pragma("unroll") for (int m = 0; m < 4; ++m) _Pragma("unroll") for (int k = 0; k < 2; ++k) dst[m][k] = *(const LAS bf16x8*)(lds + PG8_SA(b, h) + aoff + m * 2048 + k * 1024); } while (0)
#define PG8_LDB(dst, b, h) do { _Pragma("unroll") for (int n = 0; n < 2; ++n) _Pragma("unroll") for (int k = 0; k < 2; ++k) dst[n][k] = *(const LAS bf16x8*)(lds + PG8_SB(b, h) + boff + n * 2048 + k * 1024); } while (0)
#define PG8_MMA(ai, bj, At, Bt) do { if (!Sched::TAIL || (ai) * HALF + wr * 64 < nvalid) { __builtin_amdgcn_s_setprio(1); _Pragma("unroll") for (int m = 0; m < 4; ++m) _Pragma("unroll") for (int n = 0; n < 2; ++n) _Pragma("unroll") for (int k = 0; k < 2; ++k) \
        acc[ai][bj][m][n] = __builtin_amdgcn_mfma_f32_16x16x32_bf16(Bt[n][k], At[m][k], acc[ai][bj][m][n], 0, 0, 0); __builtin_amdgcn_s_setprio(0); } } while (0)
#define PG8_WAIT_V(n) asm volatile("s_waitcnt vmcnt(" #n ")" ::: "memory")
#define PG8_WAIT_L(n) asm volatile("s_waitcnt lgkmcnt(" #n ")" ::: "memory")
#define PG8_BAR __builtin_amdgcn_s_barrier()
#define PG8_SCHED __builtin_amdgcn_sched_barrier(0)
    Unit cur, nxt; int ui = 0;
    if (!S.next(0, cur)) return;
    f32x4 acc[2][2][4][2];
#pragma unroll
    for (int a = 0; a < 2; ++a)
#pragma unroll
        for (int b = 0; b < 2; ++b)
#pragma unroll
            for (int m = 0; m < 4; ++m)
#pragma unroll
                for (int n = 0; n < 2; ++n) acc[a][b][m][n] = (f32x4){0.f, 0.f, 0.f, 0.f};
    bf16x8 At[4][2], B0[2][2], B1[2][2];
    unsigned vc0[2], vc1[2], vn0[2], vn1[2];
    if constexpr (GATHER) {
#pragma unroll
        for (int i = 0; i < 2; ++i) { vc0[i] = S.arow_of(cur, RA[i]) * (unsigned)(K * 2) + CA2[i]; vc1[i] = S.arow_of(cur, HALF + RA[i]) * (unsigned)(K * 2) + CA2[i]; }
        __builtin_amdgcn_s_waitcnt(0x0F70);
    } else {
#pragma unroll
        for (int i = 0; i < 2; ++i) { vc0[i] = voffA[i]; vc1[i] = voffA[i]; }
    }
#pragma unroll
    for (int i = 0; i < 2; ++i) { vn0[i] = vc0[i]; vn1[i] = vc1[i]; }
    const char* cA = (const char*)g.A + (GATHER ? (size_t)0 : (size_t)cur.arow * K * 2); const char* cB = (const char*)g.Bt + (size_t)cur.brow * K * 2;
    PG8_STAGE(PG8_SB(0, 0), cB, voffB); PG8_STAGE(PG8_SB(0, 1), cB + hstep, voffB); PG8_STAGE_A0(PG8_SA(0, 0), cA, vc0); PG8_STAGE_A1(PG8_SA(0, 1), cA, vc1);
    if (wr == 1) PG8_BAR;
    PG8_WAIT_V(2); PG8_BAR;
    PG8_STAGE(PG8_SB(1, 0), cB + kstep, voffB); PG8_STAGE_A0(PG8_SA(1, 0), cA + kstep, vc0); PG8_STAGE(PG8_SB(1, 1), cB + hstep + kstep, voffB);
    PG8_WAIT_V(6); PG8_BAR;
#define PG8_KITER(WA) do { \
            const bool last = (t == nt - 2); \
            const char* a1 = cA + (size_t)(t + 1) * kstep; \
            const char* a2 = last ? nA : cA + (size_t)(t + 2) * kstep; const char* b2 = last ? nB : cB + (size_t)(t + 2) * kstep; \
            const char* a3 = a2 + kstep; const char* b3 = b2 + kstep; \
            unsigned vx0[2], vx1[2]; \
            _Pragma("unroll") for (int i = 0; i < 2; ++i) { vx0[i] = (GATHER && last) ? vn0[i] : vc0[i]; vx1[i] = (GATHER && last) ? vn1[i] : vc1[i]; } \
            PG8_LDB(B0, 0, 0); PG8_LDB(B1, 0, 1); PG8_SCHED; PG8_LDA(At, 0, 0); PG8_STAGE_A1(PG8_SA(1, 1), a1, vc1); \
            PG8_WAIT_V(WA); PG8_WAIT_L(0); PG8_BAR; PG8_MMA(0, 0, At, B0); PG8_MMA(0, 1, At, B1); PG8_BAR; PG8_SCHED; \
            PG8_LDA(At, 0, 1); PG8_STAGE(PG8_SB(0, 0), b2, voffB); PG8_STAGE(PG8_SB(0, 1), b2 + hstep, voffB); PG8_STAGE_A0(PG8_SA(0, 0), a2, vx0); \
            PG8_WAIT_V(WA); PG8_WAIT_L(0); PG8_BAR; PG8_MMA(1, 0, At, B0); PG8_MMA(1, 1, At, B1); PG8_BAR; PG8_SCHED; \
            PG8_LDB(B0, 1, 0); PG8_LDB(B1, 1, 1); PG8_SCHED; PG8_LDA(At, 1, 0); PG8_STAGE_A1(PG8_SA(0, 1), a2, vx1); \
            PG8_WAIT_V(8); PG8_WAIT_L(0); PG8_BAR; PG8_MMA(0, 0, At, B0); PG8_MMA(0, 1, At, B1); PG8_BAR; PG8_SCHED; \
            PG8_LDA(At, 1, 1); PG8_STAGE(PG8_SB(1, 0), b3, voffB); PG8_STAGE(PG8_SB(1, 1), b3 + hstep, voffB); PG8_STAGE_A0(PG8_SA(1, 0), a3, vx0); \
            PG8_WAIT_V(8); PG8_WAIT_L(0); PG8_BAR; PG8_MMA(1, 0, At, B0); PG8_MMA(1, 1, At, B1); PG8_BAR; PG8_SCHED; \
        } while (0)
#define PG8_UNIT_HEAD() \
        const int nvalid = Sched::TAIL ? (cur.x1 - cur.pm * BM) : BM; \
        const bool has_next = S.next(ui + 1, nxt); \
        const char* nA = has_next ? (const char*)g.A + (GATHER ? (size_t)0 : (size_t)nxt.arow * K * 2) : cA; const char* nB = has_next ? (const char*)g.Bt + (size_t)nxt.brow * K * 2 : cB; \
        if constexpr (GATHER) { \
            if (has_next) { \
                _Pragma("unroll") for (int i = 0; i < 2; ++i) { vn0[i] = S.arow_of(nxt, RA[i]) * (unsigned)(K * 2) + CA2[i]; vn1[i] = S.arow_of(nxt, HALF + RA[i]) * (unsigned)(K * 2) + CA2[i]; } \
                __builtin_amdgcn_s_waitcnt(0x0F70); \
            } \
        }
#define PG8_UNIT_TAIL() \
        if constexpr (ALIGN_EPI) { if (wr == 0) PG8_BAR; } \
        E(acc, cur, wr, wc, fr, fq); \
        if (!has_next) break; \
        _Pragma("unroll") for (int a = 0; a < 2; ++a) _Pragma("unroll") for (int b = 0; b < 2; ++b) _Pragma("unroll") for (int m = 0; m < 4; ++m) _Pragma("unroll") for (int n = 0; n < 2; ++n) acc[a][b][m][n] = (f32x4){0.f, 0.f, 0.f, 0.f}; \
        cur = nxt; cA = nA; cB = nB; ++ui; \
        _Pragma("unroll") for (int i = 0; i < 2; ++i) { vc0[i] = vn0[i]; vc1[i] = vn1[i]; } \
        if constexpr (ALIGN_EPI) { if (wr == 1) PG8_BAR; }
    do {
        {
            PG8_UNIT_HEAD()
            for (int t = 0; t < nt; t += 2) PG8_KITER(8);
            PG8_UNIT_TAIL()
        }
        for (;;) {
            PG8_UNIT_HEAD()
            { const int t = 0; PG8_KITER(24); }
            for (int t = 2; t < nt; t += 2) PG8_KITER(8);
            PG8_UNIT_TAIL()
        }
    } while (0);
    PG8_WAIT_V(0);
    if constexpr (!ALIGN_EPI) { if (wr == 0) PG8_BAR; }
    PG8_BAR;
#undef PG8_SA
#undef PG8_SB
#undef PG8_STAGE
#undef PG8_STAGE_A0
#undef PG8_STAGE_A1
#undef PG8_LDA
#undef PG8_LDB
#undef PG8_MMA
#undef PG8_WAIT_V
#undef PG8_WAIT_L
#undef PG8_KITER
#undef PG8_UNIT_HEAD
#undef PG8_UNIT_TAIL
#undef PG8_BAR
#undef PG8_SCHED
}
}

typedef GAS unsigned gu32;
#define RLX_AGENT __ATOMIC_RELAXED, __HIP_MEMORY_SCOPE_AGENT
#define XB_TMO      128
#define XB_XCNT(j)  (256  + 64 * (j))
#define XB_XSUB(j)  (1280 + 64 * (j))
#define XB_XGEN(j)  (2304 + 64 * (j))
#define XB_TOP      3328
#define XB_TOPGEN   3392
#define XCD_BAR_WORDS 3456
#define XB_SPIN_CAP (1u << 20)
__device__ __forceinline__ unsigned xb_ld(unsigned* p)              { return __hip_atomic_load(p, __ATOMIC_RELAXED, __HIP_MEMORY_SCOPE_AGENT); }
__device__ __forceinline__ unsigned xb_add(unsigned* p, unsigned v) { return __hip_atomic_fetch_add(p, v, __ATOMIC_RELAXED, __HIP_MEMORY_SCOPE_AGENT); }
__device__ __forceinline__ unsigned xb_xcc_id() { return (unsigned)__builtin_amdgcn_s_getreg((3 << 11) | 20) & 0xFu; }
#define XB_SPIN(cond, bar) do { unsigned _sp = 0; while (cond) { __builtin_amdgcn_s_sleep(1); \
    if ((++_sp & 255u) == 0u) { if (xb_ld(&(bar)[XB_TMO])) break; if (_sp > XB_SPIN_CAP) { atomicAdd(&(bar)[XB_TMO], 1u); break; } } } } while (0)
struct XcdBarrier { unsigned* bar; unsigned x; volatile LAS unsigned* st; };
__device__ __forceinline__ XcdBarrier xcd_barrier_post(unsigned* bar, volatile LAS unsigned* st) {
    XcdBarrier b; b.bar = bar; b.x = xb_xcc_id(); b.st = st;
    if (threadIdx.x == 0) (void)xb_add(&bar[XB_XCNT(b.x)], 1u);
    return b;
}
__device__ __forceinline__ void xcd_barrier_complete(unsigned* bar, unsigned x, unsigned& nloc, unsigned& nx) {
    const unsigned G = gridDim.x * gridDim.y * gridDim.z;
    unsigned sum, cnt, mine, sp = 0u;
    for (;;) {
        sum = 0u; cnt = 0u; mine = 0u;
#pragma unroll
        for (unsigned j = 0; j < 16; ++j) { const unsigned c = xb_ld(&bar[XB_XCNT(j)]); sum += c; cnt += (c > 0u) ? 1u : 0u; mine = (j == x) ? c : mine; }
        if (sum == G) break;
        __builtin_amdgcn_s_sleep(1);
        if ((++sp & 255u) == 0u) { if (xb_ld(&bar[XB_TMO])) break; if (sp > XB_SPIN_CAP) { atomicAdd(&bar[XB_TMO], 1u); break; } }
    }
    nloc = mine > 0u ? mine : 1u; nx = cnt > 0u ? cnt : 1u;
}
__device__ __forceinline__ void xcd_barrier(const XcdBarrier& b, const int tid) {
    asm volatile("s_waitcnt vmcnt(0)" ::: "memory");
    __syncthreads();
    if (tid == 0) {
        unsigned* bar = b.bar;
        __builtin_amdgcn_s_waitcnt(0);
        unsigned nloc = b.st[0], nx = b.st[1];
        if (nloc == 0u) { xcd_barrier_complete(bar, b.x, nloc, nx); b.st[0] = nloc; b.st[1] = nx; }
        const unsigned old = xb_add(&bar[XB_XSUB(b.x)], 1u);
        const unsigned gen = old / nloc;
        if (old + 1u == (gen + 1u) * nloc) {
            __builtin_amdgcn_fence(__ATOMIC_RELEASE, "agent");
            asm volatile("s_waitcnt vmcnt(0)" ::: "memory");
            const unsigned og = xb_add(&bar[XB_TOP], 1u);
            const unsigned tg = og / nx;
            if (og + 1u == (tg + 1u) * nx) xb_add(&bar[XB_TOPGEN], 1u);
            else XB_SPIN(xb_ld(&bar[XB_TOPGEN]) == tg, bar);
            __builtin_amdgcn_fence(__ATOMIC_ACQUIRE, "agent");
            xb_add(&bar[XB_XGEN(b.x)], 1u);
            asm volatile("s_waitcnt vmcnt(0)" ::: "memory");
        } else {
            XB_SPIN(xb_ld(&bar[XB_XGEN(b.x)]) == gen, bar);
            __builtin_amdgcn_fence(__ATOMIC_ACQUIRE, "agent");
            asm volatile("s_waitcnt vmcnt(0)" ::: "memory");
        }
    }
    __syncthreads();
}

struct Args {
    const float* x; const int* pos; const float* norm_mix; const float* norm_ffn; const float* norm_final;
    const float* conv_w_in; const float* conv_w; const float* conv_w_out; const float* attn_w_qkv; const float* attn_w_o;
    const float* w_coarse; const float* b_coarse; const float* w_fine; const float* b_fine; const float* w_gate; const float* w_up; const float* w_down;
    float* out; unsigned char* ws; int ph_lo, ph_hi;
};

__constant__ double INVREV[32] = {0.15915494309189535, 0.11934937021124886, 0.08949940160889101, 0.06711508300522726, 0.050329212104487035, 0.03774158471741977, 0.0283021958306234, 0.02122365276477766,
    0.015915494309189534, 0.011934937021124886, 0.008949940160889102, 0.006711508300522725, 0.005032921210448704, 0.003774158471741977, 0.00283021958306234, 0.0021223652764777662,
    0.0015915494309189536, 0.0011934937021124885, 0.0008949940160889102, 0.0006711508300522726, 0.0005032921210448703, 0.00037741584717419774, 0.00028302195830623395, 0.0002122365276477766,
    0.00015915494309189535, 0.00011934937021124886, 8.949940160889102e-05, 6.711508300522725e-05, 5.0329212104487035e-05, 3.774158471741978e-05, 2.8302195830623396e-05, 2.122365276477766e-05};

__device__ __forceinline__ int dest_row(int mode, int n0) {
    switch (mode) {
        default: return n0;
        case 1: { const int s = n0 >> 10, j = n0 & 1023; if (s == 0) return j; const int q = j >> 7; return 1024 + 256 * q + (s == 2 ? 128 : 0) + (j & 127); }
        case 2: { const int sec = n0 >> 10, j = n0 & 1023, head = j >> 6, d = j & 63, tile = head >> 2, hit = head & 3, bj = d >> 5, dd = d & 31; return sec * 1024 + tile * 256 + bj * 128 + hit * 32 + dd; }
        case 3: { const int pn = n0 >> 7; return 256 * pn + (n0 & 127); }
        case 4: { const int pn = n0 >> 7; return 256 * pn + 128 + (n0 & 127); }
    }
}
__device__ __forceinline__ void transpose_item(const float* W, int K, int N, bf16_t* WT, int mode, LAS float* scr, int item, int lane, const float* ksc = nullptr) {
    const int nblk = N / 64, kb = item / nblk, nb = item % nblk, k0 = 64 * kb, n0 = 64 * nb;
#pragma unroll
    for (int hblk = 0; hblk < 2; ++hblk) {
        f32x4 v[8];
#pragma unroll
        for (int i = 0; i < 8; ++i) { const int kk = 4 * (8 * hblk + i) + (lane >> 4), nn = 4 * (lane & 15); v[i] = *(const f32x4*)(W + (size_t)(k0 + kk) * N + n0 + nn); }
        __builtin_amdgcn_sched_barrier(0);
#pragma unroll
        for (int i = 0; i < 8; ++i) { const int kk = 4 * (8 * hblk + i) + (lane >> 4), nn = 4 * (lane & 15); f32x4 w = v[i];
            if (ksc) w *= ksc[k0 + kk];
            LAS float* s = scr + kk * 65 + nn; s[0] = w[0]; s[1] = w[1]; s[2] = w[2]; s[3] = w[3]; }
    }
    LDS_WAIT(); asm volatile("" ::: "memory");
    const int c = lane & 7;
#pragma unroll
    for (int j = 0; j < 8; ++j) { const int n = (lane >> 3) + 8 * j; const LAS float* s = scr + (8 * c) * 65 + n;
        u32x4 o; o.x = cvtpk(s[0 * 65], s[1 * 65]); o.y = cvtpk(s[2 * 65], s[3 * 65]); o.z = cvtpk(s[4 * 65], s[5 * 65]); o.w = cvtpk(s[6 * 65], s[7 * 65]);
        const int dr = dest_row(mode, n0 + (n & 32)) + (n & 31);
        *(u32x4*)(WT + (size_t)dr * K + k0 + 8 * c) = o; }
    LDS_WAIT(); asm volatile("" ::: "memory");
}

__device__ __forceinline__ void unpack8(const u32x4 t, float (&f)[8]) { f[0] = bflo(t.x); f[1] = bfhi(t.x); f[2] = bflo(t.y); f[3] = bfhi(t.y); f[4] = bflo(t.z); f[5] = bfhi(t.z); f[6] = bflo(t.w); f[7] = bfhi(t.w); }
__device__ __forceinline__ u32x4 pack8(const float (&f)[8]) { u32x4 w; w.x = cvtpk(f[0], f[1]); w.y = cvtpk(f[2], f[3]); w.z = cvtpk(f[4], f[5]); w.w = cvtpk(f[6], f[7]); return w; }
template <int MODE>
__device__ __forceinline__ void norm_rows(const float* x, bf16_t* h, float* out, const bf16_t* YS, const float* gw, bf16_t* HN, int gw_id, int lane, bool dummy) {
    float gv[2][8];
#pragma unroll
    for (int j = 0; j < 2; ++j) { const f32x4 a = *(const f32x4*)(gw + 8 * lane + 512 * j), b = *(const f32x4*)(gw + 8 * lane + 512 * j + 4);
#pragma unroll
        for (int i = 0; i < 4; ++i) { gv[j][i] = a[i]; gv[j][4 + i] = b[i]; } }
    f32x4 xa[2][2], nxa[2][2]; u32x4 hh[2], ya[2], yb[2], nhh[2], nya[2], nyb[2];
#define NR_LOAD(X, H, A, B, row) do { \
        if (MODE == 0) { const float* xr_ = x + (size_t)(row) * DM + 8 * lane; _Pragma("unroll") for (int j = 0; j < 2; ++j) { X[j][0] = *(const f32x4*)(xr_ + 512 * j); X[j][1] = *(const f32x4*)(xr_ + 512 * j + 4); } } \
        else { const bf16_t* hr_ = h + (size_t)(row) * HP + 8 * lane; const bf16_t* y0_ = YS + (size_t)(2 * (row)) * DM + 8 * lane; \
            _Pragma("unroll") for (int j = 0; j < 2; ++j) { H[j] = *(const u32x4*)(hr_ + 512 * j); A[j] = *(const u32x4*)(y0_ + 512 * j); B[j] = *(const u32x4*)(y0_ + DM + 512 * j); } } } while (0)
    NR_LOAD(xa, hh, ya, yb, gw_id * 16);
    for (int rr = 0; rr < 16; ++rr) {
        const int row = gw_id * 16 + rr;
        if (rr < 15) NR_LOAD(nxa, nhh, nya, nyb, row + 1);
        float v[2][8];
        if (MODE == 0) {
#pragma unroll
            for (int j = 0; j < 2; ++j)
#pragma unroll
                for (int i = 0; i < 4; ++i) { v[j][i] = xa[j][0][i]; v[j][4 + i] = xa[j][1][i]; }
        } else {
#pragma unroll
            for (int j = 0; j < 2; ++j) { float a[8], b[8]; unpack8(hh[j], v[j]); unpack8(ya[j], a); unpack8(yb[j], b);
                if (!dummy) {
#pragma unroll
                    for (int i = 0; i < 8; ++i) v[j][i] += a[i] + b[i]; } }
        }
        float s = 0.f;
#pragma unroll
        for (int j = 0; j < 2; ++j)
#pragma unroll
            for (int i = 0; i < 8; ++i) s += v[j][i] * v[j][i];
        const float rstd = 1.0f / sqrtf(wave_sum(s) * (1.f / DM) + EPS);
        if (MODE == 1) {
#pragma unroll
            for (int j = 0; j < 2; ++j) *(u32x4*)(h + (size_t)row * HP + 8 * lane + 512 * j) = pack8(v[j]); }
#pragma unroll
        for (int j = 0; j < 2; ++j)
#pragma unroll
            for (int i = 0; i < 8; ++i) v[j][i] *= rstd * gv[j][i];
        if (MODE == 2) {
#pragma unroll
            for (int j = 0; j < 2; ++j) { float* o = out + (size_t)row * DM + 8 * lane + 512 * j; *(f32x4*)o = (f32x4){v[j][0], v[j][1], v[j][2], v[j][3]}; *(f32x4*)(o + 4) = (f32x4){v[j][4], v[j][5], v[j][6], v[j][7]}; } }
        else {
#pragma unroll
            for (int j = 0; j < 2; ++j) *(u32x4*)(HN + (size_t)row * DM + 8 * lane + 512 * j) = pack8(v[j]); }
#pragma unroll
        for (int j = 0; j < 2; ++j) { xa[j][0] = nxa[j][0]; xa[j][1] = nxa[j][1]; hh[j] = nhh[j]; ya[j] = nya[j]; yb[j] = nyb[j]; }
    }
#undef NR_LOAD
}

constexpr int RT_WC = 0, RT_WF = 16384, RT_CNT = 81920, RT_BASE = RT_CNT + 64, RT_INFO = RT_BASE + 64;
__device__ __forceinline__ void route_phase(LAS unsigned char* lds, const bf16_t* h, const float* gw, bf16_t* HN, const float* w_coarse, const float* b_coarse, const float* w_fine, const float* b_fine,
                                            unsigned* gcnt, int* list, float* gate, float* rsc, int gw_id, int wave, int lane, int tid, bool dummy) {
    LAS f32x4* wcL = (LAS f32x4*)(lds + RT_WC); LAS f32x4* wfL = (LAS f32x4*)(lds + RT_WF);
    LAS int* cntL = (LAS int*)(lds + RT_CNT); LAS int* baseL = (LAS int*)(lds + RT_BASE); LAS int* info = (LAS int*)(lds + RT_INFO);
    for (int k = tid; k < 1024; k += 512) { const int l = (k & 511) >> 3, j = k >> 9, i = k & 7; wcL[(j * 8 + i) * 64 + l] = *(const f32x4*)(w_coarse + 4 * k);
#pragma unroll
        for (int g = 0; g < 4; ++g) wfL[g * 1024 + (j * 8 + i) * 64 + l] = *(const f32x4*)(w_fine + (size_t)g * 4096 + 4 * k); }
    if (tid < 16) cntL[tid] = 0;
    __syncthreads();
    float gv[2][8];
#pragma unroll
    for (int j = 0; j < 2; ++j) { const f32x4 a = *(const f32x4*)(gw + 8 * lane + 512 * j), b = *(const f32x4*)(gw + 8 * lane + 512 * j + 4);
#pragma unroll
        for (int i = 0; i < 4; ++i) { gv[j][i] = a[i]; gv[j][4 + i] = b[i]; } }
    const f32x4 bc = *(const f32x4*)b_coarse;
    u32x4 dd[2], ndd[2];
#define RT_LOAD(DD, row) do { const bf16_t* dr_ = h + (size_t)(row) * HP + 8 * lane; DD[0] = *(const u32x4*)dr_; DD[1] = *(const u32x4*)(dr_ + 512); } while (0)
    RT_LOAD(dd, gw_id * 16);
    for (int rr = 0; rr < 16; ++rr) {
        const int row = gw_id * 16 + rr;
        if (rr < 15) RT_LOAD(ndd, row + 1);
        float v[2][8];
        unpack8(dd[0], v[0]); unpack8(dd[1], v[1]);
        float s = 0.f;
#pragma unroll
        for (int j = 0; j < 2; ++j)
#pragma unroll
            for (int i = 0; i < 8; ++i) s += v[j][i] * v[j][i];
        const float rstd = 1.0f / sqrtf(wave_sum(s) * (1.f / DM) + EPS);
#pragma unroll
        for (int j = 0; j < 2; ++j) {
#pragma unroll
            for (int i = 0; i < 8; ++i) v[j][i] *= rstd * gv[j][i]; }
        f32x4 pc = {0.f, 0.f, 0.f, 0.f};
        {
            f32x4 wv[2][8];
#pragma unroll
            for (int j = 0; j < 2; ++j)
#pragma unroll
                for (int i = 0; i < 8; ++i) wv[j][i] = wcL[(j * 8 + i) * 64 + lane];
            __builtin_amdgcn_sched_barrier(0);
#pragma unroll
            for (int j = 0; j < 2; ++j)
#pragma unroll
                for (int i = 0; i < 8; ++i) pc += wv[j][i] * v[j][i];
        }
        float c0 = wave_sum(pc[0]) + bc[0], c1 = wave_sum(pc[1]) + bc[1], c2 = wave_sum(pc[2]) + bc[2], c3 = wave_sum(pc[3]) + bc[3];
        int gt = 0; float cm = c0; if (c1 > cm) { cm = c1; gt = 1; } if (c2 > cm) { cm = c2; gt = 2; } if (c3 > cm) { cm = c3; gt = 3; }
        const float ptop = 1.0f / (__expf(c0 - cm) + __expf(c1 - cm) + __expf(c2 - cm) + __expf(c3 - cm));
        gt = __builtin_amdgcn_readfirstlane(gt);
        f32x4 pf = {0.f, 0.f, 0.f, 0.f};
        const LAS f32x4* wfg = wfL + gt * 1024;
        {
            f32x4 wv[2][8];
#pragma unroll
            for (int j = 0; j < 2; ++j)
#pragma unroll
                for (int i = 0; i < 8; ++i) wv[j][i] = wfg[(j * 8 + i) * 64 + lane];
            __builtin_amdgcn_sched_barrier(0);
#pragma unroll
            for (int j = 0; j < 2; ++j)
#pragma unroll
                for (int i = 0; i < 8; ++i) pf += wv[j][i] * v[j][i];
        }
        const f32x4 bf = *(const f32x4*)(b_fine + 4 * gt);
        float f[4]; f[0] = wave_sum(pf[0]) + bf[0]; f[1] = wave_sum(pf[1]) + bf[1]; f[2] = wave_sum(pf[2]) + bf[2]; f[3] = wave_sum(pf[3]) + bf[3];
        int i0 = 0; float m0 = f[0];
#pragma unroll
        for (int i = 1; i < 4; ++i) if (f[i] > m0) { m0 = f[i]; i0 = i; }
        int i1 = -1; float m1 = -INFINITY;
#pragma unroll
        for (int i = 0; i < 4; ++i) if (i != i0 && f[i] > m1) { m1 = f[i]; i1 = i; }
        const float ex = __expf(m1 - m0), den = 1.0f / (1.0f + ex);
        const float g0 = ptop * den, g1 = ptop * ex * den;
        if (lane == 0) { const int e0 = gt * 4 + i0, e1 = gt * 4 + i1;
            const int p0 = __hip_atomic_fetch_add(&cntL[e0], 1, __ATOMIC_RELAXED, __HIP_MEMORY_SCOPE_WORKGROUP);
            const int p1 = __hip_atomic_fetch_add(&cntL[e1], 1, __ATOMIC_RELAXED, __HIP_MEMORY_SCOPE_WORKGROUP);
            LAS int* inf = info + (wave * 16 + rr) * 8; inf[0] = e0; inf[1] = p0; inf[2] = __float_as_int(g0); inf[3] = e1; inf[4] = p1; inf[5] = __float_as_int(g1); inf[6] = row; inf[7] = __float_as_int(rstd); }
        dd[0] = ndd[0]; dd[1] = ndd[1];
    }
#undef RT_LOAD
    __syncthreads();
    if (tid < 16) baseL[tid] = dummy ? 0 : (int)__hip_atomic_fetch_add(gcnt + tid, (unsigned)cntL[tid], __ATOMIC_RELAXED, __HIP_MEMORY_SCOPE_AGENT);
    __syncthreads();
    if (tid < 128 && !dummy) { const LAS int* inf = info + tid * 8; const int e0 = inf[0], e1 = inf[3], row = inf[6];
        const int q0 = baseL[e0] + inf[1], q1 = baseL[e1] + inf[4];
        list[e0 * 32768 + q0] = row * 2; gate[e0 * 32768 + q0] = __int_as_float(inf[2]); rsc[e0 * 32768 + q0] = __int_as_float(inf[7]);
        list[e1 * 32768 + q1] = row * 2 + 1; gate[e1 * 32768 + q1] = __int_as_float(inf[5]); rsc[e1 * 32768 + q1] = __int_as_float(inf[7]); }
    __syncthreads();
}

__device__ __forceinline__ void conv_phase(const bf16_t* Bg, const bf16_t* U, bf16_t* Y, const float* cw  , int gw_id, int lane) {
    const int rb = gw_id >> 1, c0 = (gw_id & 1) * 512 + lane * 8, t0 = rb * 32;
    float w0[8], w1[8], w2[8];
#pragma unroll
    for (int i = 0; i < 8; ++i) { w0[i] = cw[c0 + i]; w1[i] = cw[1024 + c0 + i]; w2[i] = cw[2048 + c0 + i]; }
    float um1[8], um2[8];
    const bool hasprev = (t0 & (SEQ - 1)) != 0;
    { u32x4 a = {0u, 0u, 0u, 0u}, b = {0u, 0u, 0u, 0u};
      if (hasprev) { a = *(const u32x4*)(U + (size_t)(t0 - 1) * DM + c0); b = *(const u32x4*)(U + (size_t)(t0 - 2) * DM + c0); }
#pragma unroll
      for (int i = 0; i < 4; ++i) { um1[2 * i] = bflo(a[i]); um1[2 * i + 1] = bfhi(a[i]); um2[2 * i] = bflo(b[i]); um2[2 * i + 1] = bfhi(b[i]); } }
#pragma unroll 4
    for (int t = 0; t < 32; ++t) {
        const u32x4 uu = *(const u32x4*)(U + (size_t)(t0 + t) * DM + c0), bb = *(const u32x4*)(Bg + (size_t)(t0 + t) * DM + c0);
        float uc[8], bg[8], y[8];
#pragma unroll
        for (int i = 0; i < 4; ++i) { uc[2 * i] = bflo(uu[i]); uc[2 * i + 1] = bfhi(uu[i]); bg[2 * i] = bflo(bb[i]); bg[2 * i + 1] = bfhi(bb[i]); }
#pragma unroll
        for (int i = 0; i < 8; ++i) { y[i] = bg[i] * (w0[i] * um2[i] + w1[i] * um1[i] + w2[i] * uc[i]); um2[i] = um1[i]; um1[i] = uc[i]; }
        u32x4 o; o.x = cvtpk(y[0], y[1]); o.y = cvtpk(y[2], y[3]); o.z = cvtpk(y[4], y[5]); o.w = cvtpk(y[6], y[7]);
        *(u32x4*)(Y + (size_t)(t0 + t) * DM + c0) = o;
    }
}

__device__ __forceinline__ int crow(int r, int hi) { return (r & 3) + 8 * (r >> 2) + 4 * hi; }
__device__ __forceinline__ s16x4 vtr(const LAS char* p) { typedef short v4i16_t __attribute__((ext_vector_type(4))); return __builtin_bit_cast(s16x4, __builtin_amdgcn_ds_read_tr16_b64_v4i16((LAS v4i16_t*)p)); }
template <bool MERGE>
__device__ __forceinline__ void attn_wave_unit(bf16_t* QKVh, int b, int h, int g, int r, int a0, int sh, const LAS char* Kst, const LAS char* Vst, int sub0, LAS char* ks, LAS float* wsf, float* lseG, int tl0, int lane, bool dummy,
                                               const u32x4 (&qreg)[4], const float* lse01, bf16_t* Oh, int tokbase) {
    const int r32 = lane & 31, hi = lane >> 5, lrow = lane >> 3, lch = lane & 7;
    bf16_t* base = QKVh + ((size_t)(g * 12 + (h >> 2)) * TSZ + (size_t)(b * SEQ + r) * QP + (h & 3) * 64);
    const unsigned rs = (unsigned)QP << sh;
    const int jmin = a0 >= 128 ? 0 : 4 - (a0 >> 5);
    u32x4 o0reg[4], o1reg[4]; float la[4], lb[4];
    const int kwoff = lrow * 128 + ((lch ^ lrow) * 16);
    const int kroff = r32 * 128;
    bf16x8 qr[4];
#pragma unroll
    for (int p = 0; p < 4; ++p) *(LAS u32x4*)(ks + kwoff + p * 1024) = qreg[p];
#pragma unroll
    for (int d0 = 0; d0 < 4; ++d0) qr[d0] = *(const LAS bf16x8*)(ks + kroff + (((2 * d0 + hi) ^ (r32 & 7)) * 16));
    f32x16 s[5];
    {
        bf16x8 kf[2][4];
#define AT_LDK(buf, j) do { const int sj_ = sub0 + (j) < 0 ? 0 : sub0 + (j); const LAS char* kj_ = Kst + sj_ * 4096; \
            _Pragma("unroll") for (int d0 = 0; d0 < 4; ++d0) kf[buf][d0] = *(const LAS bf16x8*)(kj_ + kroff + (((2 * d0 + hi) ^ (r32 & 7)) * 16)); } while (0)
        AT_LDK(0, 0);
#pragma unroll
        for (int j = 0; j < 5; ++j) {
            if (j + 1 < 5) AT_LDK((j + 1) & 1, j + 1);
            __builtin_amdgcn_sched_barrier(0);
            f32x16 a = {0.f, 0.f, 0.f, 0.f, 0.f, 0.f, 0.f, 0.f, 0.f, 0.f, 0.f, 0.f, 0.f, 0.f, 0.f, 0.f};
#pragma unroll
            for (int d0 = 0; d0 < 4; ++d0) a = __builtin_amdgcn_mfma_f32_32x32x16_bf16(kf[j & 1][d0], qr[d0], a, 0, 0, 0);
            s[j] = a;
        }
#undef AT_LDK
    }
    if (jmin > 0) {
#pragma unroll
        for (int j = 0; j < 4; ++j) { if (j < jmin) {
#pragma unroll
            for (int q = 0; q < 16; ++q) s[j][q] = -INFINITY; } }
    }
    if (MERGE) {
        asm volatile("" ::: "memory");
        const bf16_t* ob = QKVh + ((size_t)(h >> 2) * TSZ + (size_t)tokbase * QP + (h & 3) * 64 + lch * 8);
#pragma unroll
        for (int i = 0; i < 4; ++i) { const unsigned tl = (unsigned)(tl0 + ((8 * i + lrow) << sh)); const unsigned off = tl * (unsigned)QP; o0reg[i] = *(const u32x4*)(ob + off); o1reg[i] = *(const u32x4*)(ob + (off + 12u * (unsigned)TSZ));
            la[i] = lse01[(size_t)(tokbase + tl) * 16 + h]; lb[i] = lse01[(size_t)(HTOK + tokbase + tl) * 16 + h]; }
    }
#pragma unroll
    for (int q = 0; q < 16; ++q) { const int cr = crow(q, hi); if (cr < r32) s[0][q] = -INFINITY; if (cr > r32) s[4][q] = -INFINITY; }
    float mx;
    { float m4[4] = {-INFINITY, -INFINITY, -INFINITY, -INFINITY};
#pragma unroll
      for (int j = 0; j < 5; ++j)
#pragma unroll
          for (int q = 0; q < 16; ++q) m4[q & 3] = fmaxf(m4[q & 3], s[j][q]);
      mx = fmaxf(fmaxf(m4[0], m4[1]), fmaxf(m4[2], m4[3])); }
    { auto rr = __builtin_amdgcn_permlane32_swap(__float_as_uint(mx), __float_as_uint(mx), false, false); mx = fmaxf(__uint_as_float(rr[0]), __uint_as_float(rr[1])); }
    float l4[4] = {0.f, 0.f, 0.f, 0.f};
    u32x4 pw[5][2];
#pragma unroll
    for (int j = 0; j < 5; ++j) {
#pragma unroll
        for (int q = 0; q < 16; ++q) { s[j][q] = __builtin_amdgcn_exp2f(s[j][q] - mx); l4[q & 3] += s[j][q]; }
        pw[j][0] = (u32x4){cvtpk(s[j][0], s[j][1]), cvtpk(s[j][2], s[j][3]), cvtpk(s[j][4], s[j][5]), cvtpk(s[j][6], s[j][7])};
        pw[j][1] = (u32x4){cvtpk(s[j][8], s[j][9]), cvtpk(s[j][10], s[j][11]), cvtpk(s[j][12], s[j][13]), cvtpk(s[j][14], s[j][15])};
    }
    float l = (l4[0] + l4[1]) + (l4[2] + l4[3]);
    { auto rr = __builtin_amdgcn_permlane32_swap(__float_as_uint(l), __float_as_uint(l), false, false); l = __uint_as_float(rr[0]) + __uint_as_float(rr[1]); }
    f32x16 o[2];
#pragma unroll
    for (int q = 0; q < 16; ++q) { o[0][q] = 0.f; o[1][q] = 0.f; }
    const int vroff = ((lane >> 4) & 1) * 32 + (lane & 3) * 8 + (4 * hi + ((lane & 15) >> 2)) * 64;
    {
        bf16x8 vf[2][2][2];
#define AT_LDV(buf, j) do { const int sj_ = sub0 + (j) < 0 ? 0 : sub0 + (j); const LAS char* vp_ = Vst + sj_ * 4096 + vroff; \
            _Pragma("unroll") for (int ks2 = 0; ks2 < 2; ++ks2) _Pragma("unroll") for (int d0 = 0; d0 < 2; ++d0) { const s16x4 lo_ = vtr(vp_ + d0 * 2048 + ks2 * 1024), hh_ = vtr(vp_ + d0 * 2048 + ks2 * 1024 + 512); \
                vf[buf][ks2][d0] = (bf16x8){lo_[0], lo_[1], lo_[2], lo_[3], hh_[0], hh_[1], hh_[2], hh_[3]}; } } while (0)
        AT_LDV(0, 0);
#pragma unroll
        for (int j = 0; j < 5; ++j) {
            if (j + 1 < 5) AT_LDV((j + 1) & 1, j + 1);
            __builtin_amdgcn_sched_barrier(0);
#pragma unroll
            for (int ks2 = 0; ks2 < 2; ++ks2)
#pragma unroll
                for (int d0 = 0; d0 < 2; ++d0) o[d0] = __builtin_amdgcn_mfma_f32_32x32x16_bf16(__builtin_bit_cast(bf16x8, pw[j][ks2]), vf[j & 1][ks2][d0], o[d0], 0, 0, 0);
        }
#undef AT_LDV
    }
    LAS bf16_t* stg = (LAS bf16_t*)ks;
    const float lse = mx + __builtin_amdgcn_logf(l);
    if (hi == 0) { wsf[r32] = __builtin_amdgcn_rcpf(l); if (MERGE) wsf[32 + r32] = lse; else lseG[(size_t)(tokbase + tl0 + (r32 << sh)) * 16 + h] = lse; }
#pragma unroll
    for (int q = 0; q < 16; ++q) { const int orow = crow(q, hi); const float rl = wsf[orow];
#pragma unroll
        for (int d0 = 0; d0 < 2; ++d0) { const unsigned pk = cvtpk(o[d0][q] * rl, 0.f); stg[orow * 64 + d0 * 32 + r32] = (bf16_t)(pk & 0xffffu); } }
#pragma unroll
    for (int i = 0; i < 4; ++i) { const int row = i * 8 + lrow; const u32x4 v = *(const LAS u32x4*)(stg + row * 64 + lch * 8);
        if (!MERGE) { if (!dummy) *(u32x4*)(base + ((unsigned)(a0 + row) * rs + (unsigned)(lch * 8))) = v; }
        else {
            const int tl = tl0 + (row << sh);
            const float l0 = la[i], l1 = lb[i], l2 = wsf[32 + row]; (void)tl;
            const float mm = fmaxf(l0, fmaxf(l1, l2));
            float w0 = __builtin_amdgcn_exp2f(l0 - mm), w1 = __builtin_amdgcn_exp2f(l1 - mm), w2 = __builtin_amdgcn_exp2f(l2 - mm);
            const float inv = __builtin_amdgcn_rcpf(w0 + w1 + w2); w0 *= inv; w1 *= inv; w2 *= inv;
            u32x4 res;
#pragma unroll
            for (int k = 0; k < 4; ++k) { const float lo = w0 * bflo(o0reg[i][k]) + w1 * bflo(o1reg[i][k]) + w2 * bflo(v[k]), hh = w0 * bfhi(o0reg[i][k]) + w1 * bfhi(o1reg[i][k]) + w2 * bfhi(v[k]); res[k] = cvtpk(lo, hh); }
            *(u32x4*)(Oh + (size_t)(tokbase + tl) * DM + h * 64 + lch * 8) = res;
        } }
}
__device__ __forceinline__ void ld16_sc1x3(const void* p0, const void* p1, const void* p2, u32x4& a, u32x4& b, u32x4& c) {
    asm volatile("global_load_dwordx4 %0, %3, off sc1\n\tglobal_load_dwordx4 %1, %4, off sc1\n\tglobal_load_dwordx4 %2, %5, off sc1\n\ts_waitcnt vmcnt(0)"
                 : "=&v"(a), "=&v"(b), "=&v"(c) : "v"(p0), "v"(p1), "v"(p2) : "memory");
}
constexpr int AT_KST = 0, AT_VST = 49152, AT_PRIV = 12544, AT_WQ = 100352, AT_WQ_BYTES = 4352, AT_LSE = AT_WQ + 8 * AT_WQ_BYTES;
static_assert(AT_LSE + 12288 <= RING_BYTES, "attention LDS map");
__device__ __forceinline__ void att_win_load(u32x4 (&wreg)[12], const bf16_t* gbase, unsigned rs, int wb, int split, int tid) {
#pragma unroll
    for (int i = 0; i < 12; ++i) { const int pc = i * 512 + tid, kv = pc >= 3072 ? 1 : 0, q = pc - kv * 3072, row = q >> 3, ch = q & 7, res = row >= split ? 1 : 0; int a = wb + row - res * split; a = a < 0 ? 0 : a;
        wreg[i] = *(const u32x4*)(gbase + ((unsigned)a * rs + (unsigned)(res * QP + (1 + kv) * 4 * TSZ + ch * 8))); }
}
__device__ __forceinline__ void att_win_store(const u32x4 (&wreg)[12], LAS char* lds, int tid) {
#pragma unroll
    for (int i = 0; i < 12; ++i) { const int pc = i * 512 + tid, kv = pc >= 3072 ? 1 : 0, q = pc - kv * 3072, row = q >> 3, ch = q & 7, st = row >> 5, rw = row & 31;
        const int off = kv ? (AT_VST + st * 4096 + (ch >> 2) * 2048 + rw * 64 + (ch & 3) * 16) : (AT_KST + st * 4096 + rw * 128 + ((ch ^ (rw & 7)) * 16));
        *(LAS u32x4*)(lds + off) = wreg[i]; }
}
__device__ __forceinline__ void attn_phase_a(LAS unsigned char* ldsu, bf16_t* QKVh, float* LSE, int vcu, int G, int wave, int lane, int tid, bool dummy) {
    LAS char* lds = (LAS char*)ldsu;
    LAS char* wq = lds + AT_WQ + wave * AT_WQ_BYTES; LAS float* wsfS = (LAS float*)(wq + 4096);
    for (int q = vcu; q < 256; q += G) {
        const int b = q >> 6, h = (q >> 2) & 15, span = q & 3;
        u32x4 wreg[12], qn[4];
        for (int R = -1; R < 8; ++R) {
            int tid_l = tid; asm volatile("" : "+v"(tid_l)); const int lane_l = tid_l & 63;
            u32x4 qc[4];
#pragma unroll
            for (int p = 0; p < 4; ++p) qc[p] = qn[p];
            if (R >= 0) { att_win_store(wreg, lds, tid_l); __syncthreads(); }
            if (R + 1 < 8) { const int Rn = R + 1, g2 = Rn >> 2, r2 = g2 ? (Rn & 3) : 0;
                const int A2 = g2 ? span * 256 : span * 1024 + 256 * (Rn & 3);
                const bf16_t* gb = QKVh + ((size_t)(g2 * 12 + (h >> 2)) * TSZ + (size_t)(b * SEQ + r2) * QP + (h & 3) * 64); const unsigned rsq = (unsigned)QP << (2 * g2);
                att_win_load(wreg, gb, rsq, A2 - 128, 384, tid_l);
#pragma unroll
                for (int p = 0; p < 4; ++p) qn[p] = *(const u32x4*)(gb + ((unsigned)(A2 + 32 * wave + 8 * p + (lane_l >> 3)) * rsq + (unsigned)((lane_l & 7) * 8))); }
            if (R >= 0) {
                const int g = R >> 2, sh = 2 * g, r = g ? (R & 3) : 0;
                const int A0 = g ? span * 256 : span * 1024 + 256 * (R & 3);
                const int a0 = A0 + 32 * wave;
                const int tl0 = g == 0 ? (256 * (R & 3) + 32 * wave) : (((32 * wave) << sh) + r);
                attn_wave_unit<false>(QKVh, b, h, g, r, a0, sh, lds + AT_KST, lds + AT_VST, wave, wq, wsfS, LSE + (size_t)g * HTOK * 16, tl0, lane_l, dummy, qc, LSE, nullptr, b * SEQ + span * 1024);
                __syncthreads();
            }
        }
    }
}
__device__ __forceinline__ void att_seq_load(u32x4 (&wreg)[8], const bf16_t* gbase, unsigned rs, int tid) {
#pragma unroll
    for (int i = 0; i < 8; ++i) { const int pc = i * 512 + tid, kv = pc >= 2048 ? 1 : 0, q = pc - kv * 2048, row = q >> 3, ch = q & 7;
        wreg[i] = *(const u32x4*)(gbase + ((unsigned)row * rs + (unsigned)((1 + kv) * 4 * TSZ + ch * 8))); }
}
__device__ __forceinline__ void att_seq_store(const u32x4 (&wreg)[8], LAS char* lds, int tid) {
#pragma unroll
    for (int i = 0; i < 8; ++i) { const int pc = i * 512 + tid, kv = pc >= 2048 ? 1 : 0, q = pc - kv * 2048, row = q >> 3, ch = q & 7, st = row >> 5, rw = row & 31;
        const int off = kv ? (AT_VST + st * 4096 + (ch >> 2) * 2048 + rw * 64 + (ch & 3) * 16) : (AT_KST + st * 4096 + rw * 128 + ((ch ^ (rw & 7)) * 16));
        *(LAS u32x4*)(lds + off) = wreg[i]; }
}
__device__ __forceinline__ void attn_phase_b(LAS unsigned char* ldsu, bf16_t* QKVh, const float* LSE, bf16_t* Oh, int vcu, int G, int wave, int lane, int tid, bool dummy) {
    LAS char* lds = (LAS char*)ldsu;
    LAS char* wq = lds + AT_WQ + wave * AT_WQ_BYTES; LAS float* wsfS = (LAS float*)(wq + 4096);
    const unsigned rs = (unsigned)QP << 4;
    for (int cu = vcu; cu < 256; cu += G) {
        u32x4 wreg[8], qn[4];
        for (int i = -1; i < 4; ++i) {
            int tid_l = tid; asm volatile("" : "+v"(tid_l)); const int lane_l = tid_l & 63;
            u32x4 qc[4];
#pragma unroll
            for (int p = 0; p < 4; ++p) qc[p] = qn[p];
            if (i >= 0) { att_seq_store(wreg, lds, tid_l); __syncthreads(); }
            if (i + 1 < 4) { const int sq = cu * 4 + i + 1, b2 = sq >> 8, h2 = (sq >> 4) & 15, r2 = sq & 15;
                const bf16_t* gb = QKVh + ((size_t)(24 + (h2 >> 2)) * TSZ + (size_t)(b2 * SEQ + r2) * QP + (h2 & 3) * 64);
                att_seq_load(wreg, gb, rs, tid_l);
#pragma unroll
                for (int p = 0; p < 4; ++p) qn[p] = *(const u32x4*)(gb + ((unsigned)(32 * wave + 8 * p + (lane_l >> 3)) * rs + (unsigned)((lane_l & 7) * 8))); }
            if (i >= 0) { const int sq = cu * 4 + i, b = sq >> 8, h = (sq >> 4) & 15, r = sq & 15;
                const int a0 = 32 * wave, tl0 = (a0 << 4) + r;
                attn_wave_unit<true>(QKVh, b, h, 2, r, a0, 4, lds + AT_KST, lds + AT_VST, wave - 4, wq, wsfS, nullptr, tl0, lane_l, dummy, qc, LSE, Oh, b * SEQ);
                __syncthreads();
            }
        }
    }
}

constexpr int NWAVES = 8;
#ifndef ONLY_TYPE
#define PH_ON(t) true
#else
#define PH_ON(t) ((t) == ONLY_TYPE)
#endif
enum { T_PRO = 0, T_CIN, T_CONV, T_COUT, T_QKV, T_ATT, T_WO, T_ROUTE, T_MOE1, T_MOE2, T_NORM, T_ATTB };

typedef const __attribute__((address_space(4))) Args* KArgs;
__global__ void __launch_bounds__(NWAVES * 64, 2) hybrid_fwd(Args args_unused) {
    extern __shared__ __attribute__((aligned(16))) unsigned char lds_raw[];
    LAS unsigned char* lds = (LAS unsigned char*)lds_raw;
    volatile LAS unsigned* MISC = (volatile LAS unsigned*)(lds + MISC_OFF);
    LAS int* mtbl = (LAS int*)(lds + LDSCTL_OFF);
    KArgs ap0 = (KArgs)__builtin_amdgcn_kernarg_segment_ptr();
    const int G = gridDim.x; const int bx = blockIdx.x; const int vcu = (G % 8 == 0) ? (bx % 8) * (G / 8) + bx / 8 : bx;
    for (int u = threadIdx.x; u < (LDS_BYTES - LDSCTL_OFF) / 4; u += NWAVES * 64) ((LAS unsigned*)(lds + LDSCTL_OFF))[u] = 0u;
    __syncthreads();
    XcdBarrier bar; bar.bar = (unsigned*)((gu32*)(ap0->ws + WS_CTL) + CW_BAR); bar.x = 0; bar.st = nullptr;
    if (MK_N_LAUNCHES == 1) bar = xcd_barrier_post(bar.bar, MISC + 8);
    const int ph_lo = ap0->ph_lo, ph_hi = ap0->ph_hi;
    const int wave0 = __builtin_amdgcn_readfirstlane(threadIdx.x >> 6);
#if PROBE
    const unsigned long long t_start = __builtin_amdgcn_s_memrealtime();
#endif

    int dupstate = 0;
    for (int ph = ph_lo; ph < ph_hi; ++ph) {
#define TID_NOW(name) unsigned name##_z = 0u; asm volatile("" : "+v"(name##_z)); int name = wave0 * 64 + (int)__builtin_amdgcn_mbcnt_hi(~0u, __builtin_amdgcn_mbcnt_lo(~0u, name##_z)); const int lane = name & 63
        KArgs ap = ap0; asm volatile("" : "+s"(ap));
        int wave = wave0; asm volatile("" : "+s"(wave));
        const int gw_id = vcu * NWAVES + wave, NGW = G * NWAVES;
        unsigned char* ws = ap->ws;
        gu32* ctl = (gu32*)(ws + WS_CTL);
        bf16_t* WCIN = (bf16_t*)(ws + WS_WCIN); bf16_t* WCOUT = (bf16_t*)(ws + WS_WCOUT); bf16_t* WQKV = (bf16_t*)(ws + WS_WQKV); bf16_t* WO = (bf16_t*)(ws + WS_WO);
        bf16_t* WGU = (bf16_t*)(ws + WS_WGU); bf16_t* WDN = (bf16_t*)(ws + WS_WDN); bf16_t* HN = (bf16_t*)(ws + WS_HN);
        unsigned char* R = ws + WS_R;
        int* list = (int*)(ws + WS_LIST); float* gate = (float*)(ws + WS_GATE);
        _Float16* cosT = (_Float16*)(ws + WS_COS); _Float16* sinT = (_Float16*)(ws + WS_SIN);
        int type, L = 0, half = 0;
        if (ph == 0) type = T_PRO;
        else { int p = ph - 1, sub; bool conv;
            if (p < 7) { L = 0; sub = p; conv = true; } else if (p < 18) { L = 1; sub = p - 7; conv = false; } else if (p < 25) { L = 2; sub = p - 18; conv = true; } else { L = 3; sub = p - 25; conv = false; }
            if (conv) { type = sub == 0 ? T_CIN : sub == 1 ? T_CONV : sub == 2 ? T_COUT : sub == 3 ? T_ROUTE : sub == 4 ? T_MOE1 : sub == 5 ? T_MOE2 : T_NORM; }
            else { type = sub == 0 ? T_QKV : sub == 1 ? T_ATT : sub == 2 ? T_ATTB : sub == 3 ? T_QKV : sub == 4 ? T_ATT : sub == 5 ? T_ATTB : sub == 6 ? T_WO : sub == 7 ? T_ROUTE : sub == 8 ? T_MOE1 : sub == 9 ? T_MOE2 : T_NORM; half = (sub >= 3) ? 1 : 0; } }
        const int j2 = L >> 1;
        const bool is_dup = (type == DUP_TYPE || (DUP_TYPE == T_ATT && type == T_ATTB)) && !(type == T_NORM && L == DEPTH - 1);
        const bool dummy = is_dup && dupstate == 0;
        switch (type) {
        case T_PRO: if (PH_ON(T_PRO)) { TID_NOW(tid);
            LAS float* scr = (LAS float*)(lds + wave * 16640);
            constexpr int I0 = 2 * 16 * 48, I1 = 2 * 16 * 16, I2 = 2 * 16 * 144, I3 = 2 * 16 * 16, I4 = 64 * 16 * 8, I5 = 64 * 16 * 8, I6 = 64 * 8 * 16;
            constexpr int NITEMS = I0 + I1 + I2 + I3 + I4 + I5 + I6;
            for (int it = gw_id; it < NITEMS; it += NGW) {
                int r = it;
                if (r < I0) { const int mat = r / (16 * 48), item = r % (16 * 48); transpose_item(ap->conv_w_in + (size_t)mat * 1024 * 3072, 1024, 3072, WCIN + (size_t)mat * 3072 * 1024, 1, scr, item, lane); continue; } r -= I0;
                if (r < I1) { const int mat = r / 256, item = r % 256; transpose_item(ap->conv_w_out + (size_t)mat * 1048576, 1024, 1024, WCOUT + (size_t)mat * 1048576, 0, scr, item, lane); continue; } r -= I1;
                if (r < I2) { const int mat = r / (16 * 144), item = r % (16 * 144); transpose_item(ap->attn_w_qkv + (size_t)mat * 1024 * 9216, 1024, 9216, WQKV + (size_t)mat * 9216 * 1024, 2, scr, item, lane); continue; } r -= I2;
                if (r < I3) { const int mat = r / 256, item = r % 256; transpose_item(ap->attn_w_o + (size_t)mat * 1048576, 1024, 1024, WO + (size_t)mat * 1048576, 0, scr, item, lane); continue; } r -= I3;
                if (r < I4) { const int mat = r / 128, item = r % 128; transpose_item(ap->w_gate + (size_t)mat * 524288, 1024, 512, WGU + (size_t)mat * 1048576, 3, scr, item, lane, ap->norm_ffn + (mat >> 4) * DM); continue; } r -= I4;
                if (r < I5) { const int mat = r / 128, item = r % 128; transpose_item(ap->w_up + (size_t)mat * 524288, 1024, 512, WGU + (size_t)mat * 1048576, 4, scr, item, lane, ap->norm_ffn + (mat >> 4) * DM); continue; } r -= I5;
                { const int mat = r / 128, item = r % 128; transpose_item(ap->w_down + (size_t)mat * 524288, 512, 1024, WDN + (size_t)mat * 524288, 0, scr, item, lane); }
            }
            norm_rows<0>(ap->x, nullptr, nullptr, nullptr, ap->norm_mix, HN, gw_id, lane, false);
        } break;
        case T_CIN: if (PH_ON(T_CIN)) { TID_NOW(tid);
            pg8::Gemm g{HN, WCIN + (size_t)j2 * 3072 * 1024, 1024}; pg8::DenseOrder S; S.init(NTOK, 3072, G, bx);
            pg8::EpiConvIn E{(bf16_t*)(R + R_BG), (bf16_t*)(R + R_U)};
            pg8::gemm_phase<pg8::EpiConvIn, pg8::DenseOrder, false, true>(lds, g, S, E, tid);
        } break;
        case T_CONV: if (PH_ON(T_CONV)) { TID_NOW(tid);
            conv_phase((const bf16_t*)(R + R_BG), (const bf16_t*)(R + R_U), (bf16_t*)(R + R_Y), ap->conv_w + (size_t)j2 * 3072, gw_id, lane);
        } break;
        case T_COUT: case T_WO: if (PH_ON(T_COUT)) { TID_NOW(tid);
            const bf16_t* A = (type == T_COUT) ? (const bf16_t*)(R + R_Y) : HN;
            const bf16_t* Bt = (type == T_COUT) ? WCOUT + (size_t)j2 * 1048576 : WO + (size_t)j2 * 1048576;
            pg8::Gemm g{A, Bt, 1024}; pg8::DenseOrder S; S.init(NTOK, 1024, G, bx);
            pg8::EpiResB E{(L == 0) ? ap->x : nullptr, (const bf16_t*)ap->out, (L == DEPTH - 1) ? (bf16_t*)(R + R_H3) : (bf16_t*)ap->out};
            pg8::gemm_phase<pg8::EpiResB, pg8::DenseOrder, false, true>(lds, g, S, E, tid);
        } break;
        case T_QKV: if (PH_ON(T_QKV)) { TID_NOW(tid);
            pg8::Gemm g{HN + (size_t)half * HTOK * DM, WQKV + (size_t)j2 * 9216 * 1024, 1024}; pg8::DenseOrder S; S.init(HTOK, QKVW, G, bx);
            pg8::EpiQKV E{(bf16_t*)R, ap->pos, half * HTOK};
            pg8::gemm_phase<pg8::EpiQKV, pg8::DenseOrder, false, true>(lds, g, S, E, tid);
        } break;
        case T_ATT: if (PH_ON(T_ATT)) { TID_NOW(tid);
            attn_phase_a(lds, (bf16_t*)R, (float*)(ws + WS_LSE), vcu, G, wave, lane, tid, dummy);
        } break;
        case T_ATTB: if (PH_ON(T_ATT)) { TID_NOW(tid);
            attn_phase_b(lds, (bf16_t*)R, (const float*)(ws + WS_LSE), HN + (size_t)half * HTOK * DM, vcu, G, wave, lane, tid, dummy);
        } break;
        case T_ROUTE: if (PH_ON(T_ROUTE)) { TID_NOW(tid);
            route_phase(lds, (L == DEPTH - 1) ? (const bf16_t*)(R + R_H3) : (const bf16_t*)ap->out, ap->norm_ffn + L * DM, HN, ap->w_coarse + (size_t)L * 4096, ap->b_coarse + L * 4, ap->w_fine + (size_t)L * 16384, ap->b_fine + L * 16,
                        (unsigned*)(ctl + CW_CNT + 64 * L), list, gate, (float*)(ws + WS_RSC), gw_id, wave, lane, tid, dummy);
        } break;
        case T_MOE1: case T_MOE2: if (PH_ON(T_MOE1)) { TID_NOW(tid);
            if (tid == 0) { int uf = 0, ut = 0, hr = 0;
                for (int e = 0; e < 16; ++e) { const int c = (int)__hip_atomic_load(ctl + CW_CNT + 64 * L + e, RLX_AGENT); const int full = c >> 8, tail = (c & 255) ? 1 : 0;
                    mtbl[e] = uf; mtbl[20 + e] = ut; mtbl[40 + e] = hr; mtbl[60 + e] = c; uf += full * 4; ut += tail * 4; hr += (full + tail) * 256; }
                mtbl[16] = uf; mtbl[36] = ut; }
            __syncthreads();
            pg8::MoeOrder S{mtbl, G, bx, list};
            if (type == T_MOE1) {
                pg8::Gemm g{(L == DEPTH - 1) ? (const bf16_t*)(R + R_H3) : (const bf16_t*)ap->out, WGU + (size_t)L * 16 * 1048576, 1024};
                pg8::EpiMoeGU E{(bf16_t*)(R + R_H), (const float*)(ws + WS_RSC)};
                pg8::gemm_phase<pg8::EpiMoeGU, pg8::MoeOrder, true, true>(lds, g, S, E, tid);
            } else {
                pg8::Gemm g{(const bf16_t*)(R + R_H), WDN + (size_t)L * 16 * 524288, 512};
                pg8::EpiMoeDown E{(bf16_t*)(R + R_YS), list, gate};
                pg8::gemm_phase<pg8::EpiMoeDown, pg8::MoeOrder, false, true>(lds, g, S, E, tid);
            }
        } break;
        case T_NORM: if (PH_ON(T_NORM)) { TID_NOW(tid);
            if (L == DEPTH - 1) norm_rows<2>(nullptr, (bf16_t*)(R + R_H3), ap->out, (const bf16_t*)(R + R_YS), ap->norm_final, HN, gw_id, lane, dummy);
            else norm_rows<1>(nullptr, (bf16_t*)ap->out, ap->out, (const bf16_t*)(R + R_YS), ap->norm_mix + (L + 1) * DM, HN, gw_id, lane, dummy);
        } break;
        }
        unsigned tid2_z = 0u; asm volatile("" : "+v"(tid2_z)); const int tid2 = wave0 * 64 + (int)__builtin_amdgcn_mbcnt_hi(~0u, __builtin_amdgcn_mbcnt_lo(~0u, tid2_z));
#if PROBE
        if (bx == 0 && tid2 == 0) MISC[64 + ph] = (unsigned)(__builtin_amdgcn_s_memrealtime() - t_start);
        xcd_barrier(bar, tid2);
        if (bx == 0 && tid2 == 0) MISC[128 + ph] = (unsigned)(__builtin_amdgcn_s_memrealtime() - t_start);
#else
        if (is_dup) { if (dupstate == 0) { dupstate = 1; --ph; } else dupstate = 0; }
        if (ph + 1 < ph_hi) xcd_barrier(bar, tid2);
#endif
    }
#if PROBE
    if (bx == 0 && threadIdx.x < 64) {
        float sv = 0.f, sw = 0.f;
        for (int ph = 0; ph < NPHASE; ++ph) { const unsigned prev = ph ? MISC[128 + ph - 1] : 0u; const float tot = (float)(MISC[128 + ph] - prev) * 0.01f, work = (float)(MISC[64 + ph] - prev) * 0.01f;
            if ((PROBE_VM >> ph) & 1ull) sv += tot; if ((PROBE_WM >> ph) & 1ull) sw += PROBE_W_WORK ? work : tot; }
        float* o = ap0->out;
        if (threadIdx.x == 0) o[0] = 100.f + sv * 0.5f;
        for (int i = threadIdx.x; i < 4096; i += 64) o[4096 + i] = sw * 0.05f;
    }
#endif
}

extern "C" void kernel_launch(void* const* d_in, const int* in_sizes, int n_in, void* d_out, int out_size, void* d_ws, size_t ws_size, hipStream_t stream) {
    static int grid = 0;
    if (grid == 0) {
        if (n_in != 17 || in_sizes[0] != NTOK * DM || out_size != NTOK * DM || ws_size < WS_END) { fprintf(stderr, "kernel_launch: unexpected shapes/workspace (n_in %d, in0 %d, out %d, ws %zu < %zu)\n", n_in, n_in > 0 ? in_sizes[0] : -1, out_size, ws_size, (size_t)WS_END); grid = -1; return; }
        int dev = 0, cus = 0;
        if (hipGetDevice(&dev) != hipSuccess || hipDeviceGetAttribute(&cus, hipDeviceAttributeMultiprocessorCount, dev) != hipSuccess) { grid = -1; return; }
        if (hipFuncSetAttribute((const void*)hybrid_fwd, hipFuncAttributeMaxDynamicSharedMemorySize, LDS_BYTES) != hipSuccess) { fprintf(stderr, "kernel_launch: hipFuncSetAttribute failed\n"); grid = -1; return; }
        (void)hipGetLastError();
        grid = cus;
        if (grid != 256) fprintf(stderr, "kernel_launch: %d CUs (built for 256)\n", grid);
    }
    if (grid < 0) return;
    (void)hipMemsetAsync((char*)d_ws + WS_CTL, 0, CTL_ZERO_BYTES, stream);
    Args a{};
    a.x = (const float*)d_in[0]; a.pos = (const int*)d_in[1]; a.norm_mix = (const float*)d_in[2]; a.norm_ffn = (const float*)d_in[3]; a.norm_final = (const float*)d_in[4];
    a.conv_w_in = (const float*)d_in[5]; a.conv_w = (const float*)d_in[6]; a.conv_w_out = (const float*)d_in[7]; a.attn_w_qkv = (const float*)d_in[8]; a.attn_w_o = (const float*)d_in[9];
    a.w_coarse = (const float*)d_in[10]; a.b_coarse = (const float*)d_in[11]; a.w_fine = (const float*)d_in[12]; a.b_fine = (const float*)d_in[13];
    a.w_gate = (const float*)d_in[14]; a.w_up = (const float*)d_in[15]; a.w_down = (const float*)d_in[16];
    a.out = (float*)d_out; a.ws = (unsigned char*)d_ws;
    if (MK_N_LAUNCHES == 1) { a.ph_lo = 0; a.ph_hi = NPHASE; hipLaunchKernelGGL(hybrid_fwd, dim3(grid), dim3(NWAVES * 64), LDS_BYTES, stream, a); }
    else { for (int p = 0; p < NPHASE; ++p) { a.ph_lo = p; a.ph_hi = p + 1; hipLaunchKernelGGL(hybrid_fwd, dim3(grid), dim3(NWAVES * 64), LDS_BYTES, stream, a); } }
}
```

```cpp
#include <hip/hip_runtime.h>
#include <hip/hip_fp16.h>
#include <cstdio>
#include <cstdint>

#define LAS __attribute__((address_space(3)))
#define GAS __attribute__((address_space(1)))
typedef unsigned short bf16_t;
typedef short bf16x8 __attribute__((ext_vector_type(8)));
typedef short s16x4 __attribute__((ext_vector_type(4)));
typedef float f32x2 __attribute__((ext_vector_type(2)));
typedef float f32x4 __attribute__((ext_vector_type(4)));
typedef float f32x16 __attribute__((ext_vector_type(16)));
typedef unsigned u32x2 __attribute__((ext_vector_type(2)));
typedef unsigned u32x4 __attribute__((ext_vector_type(4)));
typedef __bf16 bf16x2_t __attribute__((ext_vector_type(2)));
typedef _Float16 h16x8 __attribute__((ext_vector_type(8)));

#ifndef PROBE
#define PROBE 0
#endif
#ifndef PROBE_VM
#define PROBE_VM 0x1ull
#endif
#ifndef PROBE_WM
#define PROBE_WM 0x0ull
#endif
#ifndef PROBE_W_WORK
#define PROBE_W_WORK 0
#endif
#ifndef DUP_TYPE
#define DUP_TYPE -1
#endif
#ifndef EPI_EXP
#define EPI_EXP 0
#endif
#ifndef MK_N_LAUNCHES
#define MK_N_LAUNCHES 1
#endif

constexpr int NTOK = 32768, DM = 1024, SEQ = 4096, DEPTH = 4;
constexpr int HTOK = 16384;
constexpr int QKVW = 9216;
constexpr int TSZ = 16384 * 256;
constexpr int QP = 256;
constexpr float EPS = 1e-6f;
constexpr float LOG2E = 1.4426950408889634f;
constexpr float C2 = 0.125f * LOG2E;
constexpr int NPHASE = 37;
constexpr int HP = 1024;

constexpr size_t MiB = 1u << 20;
constexpr size_t WS_CTL = 0, CTL_ZERO_BYTES = 32768;
constexpr size_t WS_RIMG = 256 * 1024;
constexpr size_t WS_LIST = 1 * MiB;
constexpr size_t WS_GATE = 3 * MiB;
constexpr size_t WS_LSE = 5 * MiB;
constexpr size_t WS_COS = 5 * MiB;
constexpr size_t WS_SIN = 7 * MiB;
constexpr size_t WS_RSC = 7 * MiB;
constexpr size_t WS_WCIN = 9 * MiB;
constexpr size_t WS_WCOUT = 21 * MiB;
constexpr size_t WS_WQKV = 25 * MiB;
constexpr size_t WS_WO = 61 * MiB;
constexpr size_t WS_WGU = 65 * MiB;
constexpr size_t WS_WDN = 193 * MiB;
constexpr size_t WS_HN = 257 * MiB;
constexpr size_t WS_R = 321 * MiB;
constexpr size_t WS_END = 609 * MiB;
constexpr size_t R_BG = 0, R_U = 64 * MiB, R_Y = 128 * MiB, R_D = 0;
constexpr size_t R_H3 = 202 * MiB;
constexpr size_t R_H = 0, R_YS = 72 * MiB;
constexpr int CW_CNT = 1024;
constexpr int CW_BAR = 4096;

constexpr int RING_BYTES = 147456;
constexpr int LDSCTL_OFF = RING_BYTES, MISC_OFF = LDSCTL_OFF + 1024;
constexpr int LDS_BYTES = 155648;

__device__ __forceinline__ unsigned cvtpk(float lo, float hi) { f32x2 v = {lo, hi}; bf16x2_t b = __builtin_convertvector(v, bf16x2_t); return __builtin_bit_cast(unsigned, b); }
__device__ __forceinline__ float bflo(unsigned u) { return __uint_as_float(u << 16); }
__device__ __forceinline__ float bfhi(unsigned u) { return __uint_as_float(u & 0xffff0000u); }
__device__ __forceinline__ float dpp_xadd(float v, const int ctrl) { return v; }
#define DPP_ADD(v, ctrl) (v) += __int_as_float(__builtin_amdgcn_update_dpp(0, __float_as_int(v), (ctrl), 0xF, 0xF, true))
__device__ __forceinline__ float wave_sum(float v) {
    DPP_ADD(v, 0xB1);
    DPP_ADD(v, 0x4E);
    DPP_ADD(v, 0x141);
    DPP_ADD(v, 0x140);
    { auto r = __builtin_amdgcn_permlane16_swap(__float_as_uint(v), __float_as_uint(v), false, false); v = __uint_as_float(r[0]) + __uint_as_float(r[1]); }
    { auto r = __builtin_amdgcn_permlane32_swap(__float_as_uint(v), __float_as_uint(v), false, false); v = __uint_as_float(r[0]) + __uint_as_float(r[1]); }
    return v;
}
#define LDS_WAIT() asm volatile("s_waitcnt lgkmcnt(0)" ::: "memory")
#define VM_WAIT() asm volatile("s_waitcnt vmcnt(0)" ::: "memory")

namespace pg8 {
constexpr int BM = 256, BK = 64, HALF = 128, HTB = HALF * BK * 2, STAGE_BYTES = 8 * HTB, NXCD = 8, WGM = 8;
__host__ __device__ __forceinline__ int lds_byte(int r, int c) { const int st = (r >> 4) * 2 + (c >> 5), rr = r & 15, cc = c & 31, ob = rr * 64 + cc * 2; return st * 1024 + (ob ^ (((ob >> 9) & 1) << 5)); }
__host__ __device__ __forceinline__ void stage_rc(int b, int& R, int& C) { const int st = b / 1024, sb = b % 1024, swz = sb ^ (((sb >> 9) & 1) << 5); R = (st >> 1) * 16 + swz / 64; C = (st & 1) * 32 + (swz % 64) / 2; }
__host__ __device__ __forceinline__ int perm32(int rho) { const int n = rho >> 4, i = rho & 15; return 8 * (i >> 2) + 4 * n + (i & 3); }

struct Unit { int pm, pn, arow, brow, x0, x1; };
struct Gemm { const bf16_t* A; const bf16_t* Bt; int K; };

struct DenseOrder {
    static constexpr bool TAIL = false;
    int nM, nN, nwg, G, c;
    __device__ void init(int M, int N, int G_, int c_) { nM = M / BM; nN = N / BM; nwg = nM * nN; G = G_; c = c_; }
    __device__ bool next(int i, Unit& u) const {
        const long L = (long)i * G + c; if (L >= nwg) return false;
        int wgid = (int)L; { const int q = nwg / NXCD, r = nwg % NXCD, xcd = wgid % NXCD, off = wgid / NXCD; wgid = (xcd < r ? xcd * (q + 1) : r * (q + 1) + (xcd - r) * q) + off; }
        const int nig = WGM * nN, gid = wgid / nig, fm = gid * WGM, gsz = (nM - fm) < WGM ? (nM - fm) : WGM;
        u.pm = fm + ((wgid % nig) % gsz); u.pn = (wgid % nig) / gsz; u.arow = u.pm * BM; u.brow = u.pn * BM; u.x0 = 0; u.x1 = 0; return true;
    }
    __device__ __forceinline__ unsigned arow_of(const Unit&, int) const { return 0u; }
};
struct MoeOrder {
    static constexpr bool TAIL = true;
    const LAS int* tbl; int G, c; const int* list;
    static constexpr int MAXU = 12;
    __device__ bool next(int i, Unit& u) const {
        if (i >= MAXU) return false;
        const int d = __builtin_amdgcn_readfirstlane(tbl[80 + i]); if (d < 0) return false;
        const int e = d & 15, pn = (d >> 4) & 3, mt = d >> 6;
        u.pm = mt; u.pn = pn; u.x0 = e; u.x1 = __builtin_amdgcn_readfirstlane(tbl[60 + e]);
        u.arow = __builtin_amdgcn_readfirstlane(tbl[40 + e]) + mt * BM; u.brow = e * 1024 + pn * BM; return true;
    }
    __device__ __forceinline__ unsigned arow_of(const Unit& u, int r) const { const int pos = u.pm * BM + r; return pos < u.x1 ? (unsigned)(list[u.x0 * 32768 + pos] >> 1) : 0u; }
};

struct EpiConvIn {
    static constexpr bool PERM = true; static constexpr int NST = 8;
    bf16_t* Bg; bf16_t* U;
    __device__ __forceinline__ int nst(const Unit& u) const { return u.pn < 4 ? 16 : 8; }
    __device__ __forceinline__ void operator()(const f32x4 (&acc)[2][2][4][2], const Unit& u, int wr, int wc, int fr, int fq) const {
        const int row0 = u.pm * BM + wr * 64 + fr;
        if (u.pn < 4) {
            const int col0 = u.pn * BM + wc * 32 + 8 * fq;
#pragma unroll
            for (int ai = 0; ai < 2; ++ai)
#pragma unroll
                for (int m = 0; m < 4; ++m) { bf16_t* rowp = Bg + (size_t)(row0 + ai * HALF + m * 16) * DM + col0;
#pragma unroll
                    for (int bj = 0; bj < 2; ++bj) { const f32x4 v0 = acc[ai][bj][m][0], v1 = acc[ai][bj][m][1]; u32x4 w; w.x = cvtpk(v0[0], v0[1]); w.y = cvtpk(v0[2], v0[3]); w.z = cvtpk(v1[0], v1[1]); w.w = cvtpk(v1[2], v1[3]);
                        *(u32x4*)(rowp + bj * HALF) = w; } }
        } else {
            const int col0 = (u.pn - 4) * HALF + wc * 32 + 8 * fq;
#pragma unroll
            for (int ai = 0; ai < 2; ++ai)
#pragma unroll
                for (int m = 0; m < 4; ++m) { bf16_t* rowp = U + (size_t)(row0 + ai * HALF + m * 16) * DM + col0;
                    const f32x4 v0 = acc[ai][0][m][0] * acc[ai][1][m][0], v1 = acc[ai][0][m][1] * acc[ai][1][m][1]; u32x4 w; w.x = cvtpk(v0[0], v0[1]); w.y = cvtpk(v0[2], v0[3]); w.z = cvtpk(v1[0], v1[1]); w.w = cvtpk(v1[2], v1[3]);
                    *(u32x2*)rowp = (u32x2){w.x, w.y}; *(u32x2*)(rowp + 4) = (u32x2){w.z, w.w}; }
        }
    }
};
struct EpiDelta {
    static constexpr bool PERM = true; static constexpr int NST = 16;
    bf16_t* D;
    __device__ __forceinline__ int nst(const Unit&) const { return 16; }
    __device__ __forceinline__ void operator()(const f32x4 (&acc)[2][2][4][2], const Unit& u, int wr, int wc, int fr, int fq) const {
        const int row0 = u.pm * BM + wr * 64 + fr, col0 = u.pn * BM + wc * 32 + 8 * fq;
#pragma unroll
        for (int ai = 0; ai < 2; ++ai)
#pragma unroll
            for (int m = 0; m < 4; ++m) { bf16_t* rowp = D + (size_t)(row0 + ai * HALF + m * 16) * DM + col0;
#pragma unroll
                for (int bj = 0; bj < 2; ++bj) { const f32x4 v0 = acc[ai][bj][m][0], v1 = acc[ai][bj][m][1]; u32x4 w; w.x = cvtpk(v0[0], v0[1]); w.y = cvtpk(v0[2], v0[3]); w.z = cvtpk(v1[0], v1[1]); w.w = cvtpk(v1[2], v1[3]);
                    *(u32x4*)(rowp + bj * HALF) = w; } }
    }
};
struct EpiResB {
    static constexpr bool PERM = true; static constexpr int NST = 16;
    const float* xf; const bf16_t* hin; bf16_t* h;
    __device__ __forceinline__ int nst(const Unit&) const { return 16; }
    __device__ __forceinline__ void operator()(const f32x4 (&acc)[2][2][4][2], const Unit& u, int wr, int wc, int fr, int fq) const {
        const int row0 = u.pm * BM + wr * 64 + fr, col0 = u.pn * BM + wc * 32 + 8 * fq;
        if (xf) {
#pragma unroll
            for (int ai = 0; ai < 2; ++ai) {
                f32x4 b[4][2][2];
#pragma unroll
                for (int m = 0; m < 4; ++m)
#pragma unroll
                    for (int bj = 0; bj < 2; ++bj) { const float* xp = xf + (size_t)(row0 + ai * HALF + m * 16) * DM + col0 + bj * HALF; b[m][bj][0] = *(const f32x4*)xp; b[m][bj][1] = *(const f32x4*)(xp + 4); }
                __builtin_amdgcn_sched_barrier(0);
#pragma unroll
                for (int m = 0; m < 4; ++m) { bf16_t* rowp = h + (size_t)(row0 + ai * HALF + m * 16) * HP + col0;
#pragma unroll
                    for (int bj = 0; bj < 2; ++bj) { const f32x4 v0 = acc[ai][bj][m][0] + b[m][bj][0], v1 = acc[ai][bj][m][1] + b[m][bj][1]; u32x4 w; w.x = cvtpk(v0[0], v0[1]); w.y = cvtpk(v0[2], v0[3]); w.z = cvtpk(v1[0], v1[1]); w.w = cvtpk(v1[2], v1[3]);
                        *(u32x4*)(rowp + bj * HALF) = w; } }
                __builtin_amdgcn_sched_barrier(0);
            }
        } else {
            u32x4 t[2][4][2];
#pragma unroll
            for (int ai = 0; ai < 2; ++ai)
#pragma unroll
                for (int m = 0; m < 4; ++m)
#pragma unroll
                    for (int bj = 0; bj < 2; ++bj) t[ai][m][bj] = *(const u32x4*)(hin + (size_t)(row0 + ai * HALF + m * 16) * HP + col0 + bj * HALF);
            __builtin_amdgcn_sched_barrier(0);
#pragma unroll
            for (int ai = 0; ai < 2; ++ai)
#pragma unroll
                for (int m = 0; m < 4; ++m) { bf16_t* rowp = h + (size_t)(row0 + ai * HALF + m * 16) * HP + col0;
#pragma unroll
                    for (int bj = 0; bj < 2; ++bj) { const u32x4 tt = t[ai][m][bj]; const f32x4 b0 = (f32x4){bflo(tt.x), bfhi(tt.x), bflo(tt.y), bfhi(tt.y)}, b1 = (f32x4){bflo(tt.z), bfhi(tt.z), bflo(tt.w), bfhi(tt.w)};
                        const f32x4 v0 = acc[ai][bj][m][0] + b0, v1 = acc[ai][bj][m][1] + b1; u32x4 w; w.x = cvtpk(v0[0], v0[1]); w.y = cvtpk(v0[2], v0[3]); w.z = cvtpk(v1[0], v1[1]); w.w = cvtpk(v1[2], v1[3]);
                        *(u32x4*)(rowp + bj * HALF) = w; } }
        }
    }
};
struct EpiRes {
    static constexpr bool PERM = false; static constexpr int NST = 16;
    const float* base; float* out;
    __device__ __forceinline__ int nst(const Unit&) const { return 16; }
    __device__ __forceinline__ void operator()(const f32x4 (&acc)[2][2][4][2], const Unit& u, int wr, int wc, int fr, int fq) const {
        const int col0 = u.pn * BM + wc * 32 + 4 * fq;
#pragma unroll
        for (int ai = 0; ai < 2; ++ai)
#pragma unroll
            for (int m = 0; m < 4; ++m) { const size_t off = (size_t)(u.pm * BM + ai * HALF + wr * 64 + m * 16 + fr) * DM + col0;
                f32x4 b[2][2];
#pragma unroll
                for (int bj = 0; bj < 2; ++bj)
#pragma unroll
                    for (int n = 0; n < 2; ++n) b[bj][n] = *(const f32x4*)(base + off + bj * HALF + n * 16);
#pragma unroll
                for (int bj = 0; bj < 2; ++bj)
#pragma unroll
                    for (int n = 0; n < 2; ++n) *(f32x4*)(out + off + bj * HALF + n * 16) = b[bj][n] + acc[ai][bj][m][n];
                if (m & 1) asm volatile("" ::: "memory"); }
    }
};
struct EpiQKV {
    static constexpr bool PERM = true; static constexpr int NST = 16;
    bf16_t* O; const int* pos; int tok0;
    __device__ __forceinline__ int nst(const Unit&) const { return 16; }
    __device__ __forceinline__ void operator()(const f32x4 (&acc)[2][2][4][2], const Unit& u, int wr, int wc, int fr, int fq) const {
        const int sec = u.pn >> 2, kind = sec % 3, head = (u.pn & 3) * 4 + wc;
        const int col = sec * 1024 + head * 64 + 8 * fq;
        const int rbase = u.pm * BM + wr * 64 + fr;
        float pf[2][4];
        float ir[8];
        if (kind < 2) {
#pragma unroll
            for (int ai = 0; ai < 2; ++ai)
#pragma unroll
                for (int m = 0; m < 4; ++m) pf[ai][m] = (float)pos[tok0 + rbase + ai * HALF + m * 16];
            int fql = fq; asm volatile("" : "+v"(fql));
#pragma unroll
            for (int i = 0; i < 8; ++i) ir[i] = __builtin_amdgcn_exp2f(-(float)(8 * fql + i) * 0.41524101186092029f) * 0.15915494309189535f;
        }
#pragma unroll
        for (int ai = 0; ai < 2; ++ai)
#pragma unroll
            for (int m = 0; m < 4; ++m) { const int rloc = rbase + ai * HALF + m * 16;
                bf16_t* rowp = O + ((size_t)u.pn * TSZ + (size_t)rloc * QP + wc * 64 + 8 * fq); (void)col;
                f32x4 a0 = acc[ai][0][m][0], a1 = acc[ai][0][m][1], b0 = acc[ai][1][m][0], b1 = acc[ai][1][m][1];
                if (kind < 2) {
#pragma unroll
                    for (int i = 0; i < 4; ++i) {
                        const float f0 = __builtin_amdgcn_fractf(pf[ai][m] * ir[i]), f1 = __builtin_amdgcn_fractf(pf[ai][m] * ir[4 + i]);
                        const float c0 = __builtin_amdgcn_cosf(f0), s0 = __builtin_amdgcn_sinf(f0), c1 = __builtin_amdgcn_cosf(f1), s1 = __builtin_amdgcn_sinf(f1);
                        const float x1 = a0[i], x2 = b0[i], y1 = a1[i], y2 = b1[i];
                        a0[i] = x1 * c0 - x2 * s0; b0[i] = x2 * c0 + x1 * s0; a1[i] = y1 * c1 - y2 * s1; b1[i] = y2 * c1 + y1 * s1; }
                }
                u32x4 w; w.x = cvtpk(a0[0], a0[1]); w.y = cvtpk(a0[2], a0[3]); w.z = cvtpk(a1[0], a1[1]); w.w = cvtpk(a1[2], a1[3]); *(u32x4*)rowp = w;
                w.x = cvtpk(b0[0], b0[1]); w.y = cvtpk(b0[2], b0[3]); w.z = cvtpk(b1[0], b1[1]); w.w = cvtpk(b1[2], b1[3]); *(u32x4*)(rowp + 32) = w; }
    }
};
struct EpiMoeGU {
    static constexpr bool PERM = true; static constexpr int NST = 8;
    bf16_t* H; const float* rsc;
    __device__ __forceinline__ int nst(const Unit&) const { return 8; }
    __device__ __forceinline__ void operator()(const f32x4 (&acc)[2][2][4][2], const Unit& u, int wr, int wc, int fr, int fq) const {
        const int col0 = u.pn * HALF + wc * 32 + 8 * fq;
        float rs[2][4];
#pragma unroll
        for (int ai = 0; ai < 2; ++ai)
#pragma unroll
            for (int m = 0; m < 4; ++m) { const int pos = u.pm * BM + ai * HALF + wr * 64 + m * 16 + fr, pc = pos < u.x1 ? pos : u.x1 - 1; const float r = rsc[u.x0 * 32768 + pc]; rs[ai][m] = pos < u.x1 ? r : 0.f; }
#pragma unroll
        for (int ai = 0; ai < 2; ++ai)
#pragma unroll
            for (int m = 0; m < 4; ++m) { bf16_t* rowp = H + (size_t)(u.arow + ai * HALF + wr * 64 + m * 16 + fr) * 512 + col0;
                float o[8];
#pragma unroll
                for (int n = 0; n < 2; ++n)
#pragma unroll
                    for (int i = 0; i < 4; ++i) { const float gt = acc[ai][0][m][n][i] * rs[ai][m], up = acc[ai][1][m][n][i] * rs[ai][m];
                        o[n * 4 + i] = gt * __builtin_amdgcn_rcpf(1.f + __builtin_amdgcn_exp2f(-gt * LOG2E)) * up; }
                u32x4 w; w.x = cvtpk(o[0], o[1]); w.y = cvtpk(o[2], o[3]); w.z = cvtpk(o[4], o[5]); w.w = cvtpk(o[6], o[7]); *(u32x2*)rowp = (u32x2){w.x, w.y}; *(u32x2*)(rowp + 4) = (u32x2){w.z, w.w}; }
    }
};
struct EpiMoeDown {
    static constexpr bool PERM = true; static constexpr int NST = 16;
    bf16_t* YS; const int* list; const float* gate;
    __device__ __forceinline__ int nst(const Unit& u) const { return (u.x1 - u.pm * BM >= BM) ? 16 : 0; }
    __device__ __forceinline__ void operator()(const f32x4 (&acc)[2][2][4][2], const Unit& u, int wr, int wc, int fr, int fq) const {
        const int col0 = u.pn * BM + wc * 32 + 8 * fq;
        int dstv[2][4]; float gwv[2][4];
#pragma unroll
        for (int ai = 0; ai < 2; ++ai)
#pragma unroll
            for (int m = 0; m < 4; ++m) { const int pos = u.pm * BM + ai * HALF + wr * 64 + m * 16 + fr, pc = pos < u.x1 ? pos : u.x1 - 1; dstv[ai][m] = list[u.x0 * 32768 + pc]; gwv[ai][m] = gate[u.x0 * 32768 + pc]; }
        __builtin_amdgcn_sched_barrier(0);
#pragma unroll
        for (int ai = 0; ai < 2; ++ai) {
#pragma unroll
            for (int m = 0; m < 4; ++m) { const int pos = u.pm * BM + ai * HALF + wr * 64 + m * 16 + fr;
                { const bool ok = pos < u.x1; const int dst = ok ? dstv[ai][m] : 65536  ; const float gw = ok ? gwv[ai][m] : 0.f;
                    bf16_t* rowp = YS + (size_t)dst * DM + col0;
#pragma unroll
                    for (int bj = 0; bj < 2; ++bj) { const f32x4 v0 = acc[ai][bj][m][0] * gw, v1 = acc[ai][bj][m][1] * gw; u32x4 w; w.x = cvtpk(v0[0], v0[1]); w.y = cvtpk(v0[2], v0[3]); w.z = cvtpk(v1[0], v1[1]); w.w = cvtpk(v1[2], v1[3]);
                        *(u32x4*)(rowp + bj * HALF) = w; } } } }
    }
};

template <class Epi, class Sched, bool GATHER, bool ALIGN_EPI>
__device__ __forceinline__ void gemm_phase(LAS unsigned char* lds, const Gemm g, const Sched& S, const Epi& E, const int tid) {
    const int wid = __builtin_amdgcn_readfirstlane(tid >> 6), lane = tid & 63, wr = wid >> 2, wc = wid & 3, fr = lane & 15, fq = lane >> 4;
    const int K = g.K, nt = K / BK;
    unsigned voffA[2], voffB[2]; int RA[2]; unsigned CA2[2];
#pragma unroll
    for (int i = 0; i < 2; ++i) { int R, C; stage_rc(tid * 16 + i * 8192, R, C); const int Rb = Epi::PERM ? ((R & ~31) + perm32(R & 31)) : R;
        voffA[i] = (unsigned)(R * K + C) * 2u; voffB[i] = (unsigned)(Rb * K + C) * 2u; RA[i] = R; CA2[i] = (unsigned)C * 2u; }
    const size_t kstep = (size_t)(BK * 2);
    const size_t hstep = (size_t)HALF * K * 2;
    const size_t hstepA = GATHER ? (size_t)0 : hstep;
    const unsigned ldsw = (unsigned)wid * 1024u;
    const int aoff = lds_byte(wr * 64 + fr, fq * 8), boff = lds_byte(wc * 32 + fr, fq * 8);
#define PG8_SA(b, h) (((b) * 2 + (h)) * HTB)
#define PG8_SB(b, h) ((4 + (b) * 2 + (h)) * HTB)
#define PG8_STAGE(bufoff, gbase, voff) do { _Pragma("unroll") for (int _i = 0; _i < 2; ++_i) \
        __builtin_amdgcn_global_load_lds((const unsigned*)((const char*)(gbase) + (voff)[_i]), (LAS unsigned*)(lds + (bufoff) + ldsw + _i * 8192), 16, 0, 0); } while (0)
#define PG8_STAGE_A0(bufoff, ptr, V0) PG8_STAGE(bufoff, ptr, V0)
#define PG8_STAGE_A1(bufoff, ptr, V1) PG8_STAGE(bufoff, (ptr) + hstepA, V1)
#define PG8_LDA(dst, b, h) do { _Pragma("unroll") for (int m = 0; m < 4; ++m) _Pragma("unroll") for (int k = 0; k < 2; ++k) dst[m][k] = *(const LAS bf16x8*)(lds + PG8_SA(b, h) + aoff + m * 2048 + k * 1024); } while (0)
#define PG8_LDB(dst, b, h) do { _Pragma("unroll") for (int n = 0; n < 2; ++n) _Pragma("unroll") for (int k = 0; k < 2; ++k) dst[n][k] = *(const LAS bf16x8*)(lds + PG8_SB(b, h) + boff + n * 2048 + k * 1024); } while (0)
#define PG8_MMA(ai, bj, At, Bt) do { if (!Sched::TAIL || (ai) * HALF + wr * 64 < nvalid) { __builtin_amdgcn_s_setprio(1); _Pragma("unroll") for (int m = 0; m < 4; ++m) _Pragma("unroll") for (int n = 0; n < 2; ++n) _Pragma("unroll") for (int k = 0; k < 2; ++k) \
        acc[ai][bj][m][n] = __builtin_amdgcn_mfma_f32_16x16x32_bf16(Bt[n][k], At[m][k], acc[ai][bj][m][n], 0, 0, 0); __builtin_amdgcn_s_setprio(0); } } while (0)
#define PG8_WAIT_V(n) asm volatile("s_waitcnt vmcnt(" #n ")" ::: "memory")
#define PG8_WAIT_L(n) asm volatile("s_waitcnt lgkmcnt(" #n ")" ::: "memory")
#define PG8_BAR __builtin_amdgcn_s_barrier()
#define PG8_SCHED __builtin_amdgcn_sched_barrier(0)
    Unit cur, nxt; int ui = 0;
    if (!S.next(0, cur)) return;
    f32x4 acc[2][2][4][2];
#pragma unroll
    for (int a = 0; a < 2; ++a)
#pragma unroll
        for (int b = 0; b < 2; ++b)
#pragma unroll
            for (int m = 0; m < 4; ++m)
#pragma unroll
                for (int n = 0; n < 2; ++n) acc[a][b][m][n] = (f32x4){0.f, 0.f, 0.f, 0.f};
    bf16x8 At[4][2], B0[2][2], B1[2][2];
    unsigned vc0[2], vc1[2], vn0[2], vn1[2];
    if constexpr (GATHER) {
#pragma unroll
        for (int i = 0; i < 2; ++i) { vc0[i] = S.arow_of(cur, RA[i]) * (unsigned)(K * 2) + CA2[i]; vc1[i] = S.arow_of(cur, HALF + RA[i]) * (unsigned)(K * 2) + CA2[i]; }
        __builtin_amdgcn_s_waitcnt(0x0F70);
    } else {
#pragma unroll
        for (int i = 0; i < 2; ++i) { vc0[i] = voffA[i]; vc1[i] = voffA[i]; }
    }
#pragma unroll
    for (int i = 0; i < 2; ++i) { vn0[i] = vc0[i]; vn1[i] = vc1[i]; }
    const char* cA = (const char*)g.A + (GATHER ? (size_t)0 : (size_t)cur.arow * K * 2); const char* cB = (const char*)g.Bt + (size_t)cur.brow * K * 2;
    PG8_STAGE(PG8_SB(0, 0), cB, voffB); PG8_STAGE(PG8_SB(0, 1), cB + hstep, voffB); PG8_STAGE_A0(PG8_SA(0, 0), cA, vc0); PG8_STAGE_A1(PG8_SA(0, 1), cA, vc1);
    if (wr == 1) PG8_BAR;
    PG8_WAIT_V(2); PG8_BAR;
    PG8_STAGE(PG8_SB(1, 0), cB + kstep, voffB); PG8_STAGE_A0(PG8_SA(1, 0), cA + kstep, vc0); PG8_STAGE(PG8_SB(1, 1), cB + hstep + kstep, voffB);
    PG8_WAIT_V(6); PG8_BAR;
#define PG8_KITER(WA) do { \
            const bool last = (t == nt - 2); \
            const char* a1 = cA + (size_t)(t + 1) * kstep; \
            const char* a2 = last ? nA : cA + (size_t)(t + 2) * kstep; const char* b2 = last ? nB : cB + (size_t)(t + 2) * kstep; \
            const char* a3 = a2 + kstep; const char* b3 = b2 + kstep; \
            unsigned vx0[2], vx1[2]; \
            _Pragma("unroll") for (int i = 0; i < 2; ++i) { vx0[i] = (GATHER && last) ? vn0[i] : vc0[i]; vx1[i] = (GATHER && last) ? vn1[i] : vc1[i]; } \
            PG8_LDB(B0, 0, 0); PG8_LDB(B1, 0, 1); PG8_SCHED; PG8_LDA(At, 0, 0); PG8_STAGE_A1(PG8_SA(1, 1), a1, vc1); \
            PG8_WAIT_V(WA); PG8_WAIT_L(0); PG8_BAR; PG8_MMA(0, 0, At, B0); PG8_MMA(0, 1, At, B1); PG8_BAR; PG8_SCHED; \
            PG8_LDA(At, 0, 1); PG8_STAGE(PG8_SB(0, 0), b2, voffB); PG8_STAGE(PG8_SB(0, 1), b2 + hstep, voffB); PG8_STAGE_A0(PG8_SA(0, 0), a2, vx0); \
            PG8_WAIT_V(WA); PG8_WAIT_L(0); PG8_BAR; PG8_MMA(1, 0, At, B0); PG8_MMA(1, 1, At, B1); PG8_BAR; PG8_SCHED; \
            PG8_LDB(B0, 1, 0); PG8_LDB(B1, 1, 1); PG8_SCHED; PG8_LDA(At, 1, 0); PG8_STAGE_A1(PG8_SA(0, 1), a2, vx1); \
            PG8_WAIT_V(8); PG8_WAIT_L(0); PG8_BAR; PG8_MMA(0, 0, At, B0); PG8_MMA(0, 1, At, B1); PG8_BAR; PG8_SCHED; \
            PG8_LDA(At, 1, 1); PG8_STAGE(PG8_SB(1, 0), b3, voffB); PG8_STAGE(PG8_SB(1, 1), b3 + hstep, voffB); PG8_STAGE_A0(PG8_SA(1, 0), a3, vx0); \
            PG8_WAIT_V(8); PG8_WAIT_L(0); PG8_BAR; PG8_MMA(1, 0, At, B0); PG8_MMA(1, 1, At, B1); PG8_BAR; PG8_SCHED; \
        } while (0)
#define PG8_UNIT_HEAD() \
        const int nvalid = Sched::TAIL ? (cur.x1 - cur.pm * BM) : BM; \
        const bool has_next = S.next(ui + 1, nxt); \
        const char* nA = has_next ? (const char*)g.A + (GATHER ? (size_t)0 : (size_t)nxt.arow * K * 2) : cA; const char* nB = has_next ? (const char*)g.Bt + (size_t)nxt.brow * K * 2 : cB; \
        if constexpr (GATHER) { \
            if (has_next) { \
                _Pragma("unroll") for (int i = 0; i < 2; ++i) { vn0[i] = S.arow_of(nxt, RA[i]) * (unsigned)(K * 2) + CA2[i]; vn1[i] = S.arow_of(nxt, HALF + RA[i]) * (unsigned)(K * 2) + CA2[i]; } \
                __builtin_amdgcn_s_waitcnt(0x0F70); \
            } \
        }
#define PG8_UNIT_TAIL() \
        if constexpr (ALIGN_EPI) { if (wr == 0) PG8_BAR; } \
        E(acc, cur, wr, wc, fr, fq); \
        if (!has_next) break; \
        _Pragma("unroll") for (int a = 0; a < 2; ++a) _Pragma("unroll") for (int b = 0; b < 2; ++b) _Pragma("unroll") for (int m = 0; m < 4; ++m) _Pragma("unroll") for (int n = 0; n < 2; ++n) acc[a][b][m][n] = (f32x4){0.f, 0.f, 0.f, 0.f}; \
        cur = nxt; cA = nA; cB = nB; ++ui; \
        _Pragma("unroll") for (int i = 0; i < 2; ++i) { vc0[i] = vn0[i]; vc1[i] = vn1[i]; } \
        if constexpr (ALIGN_EPI) { if (wr == 1) PG8_BAR; }
    do {
        {
            PG8_UNIT_HEAD()
            for (int t = 0; t < nt; t += 2) PG8_KITER(8);
            PG8_UNIT_TAIL()
        }
        for (;;) {
            PG8_UNIT_HEAD()
            { const int t = 0; if constexpr (Epi::NST >= 16) PG8_KITER(24); else PG8_KITER(16); }
            for (int t = 2; t < nt; t += 2) PG8_KITER(8);
            PG8_UNIT_TAIL()
        }
    } while (0);
    PG8_WAIT_V(0);
    if constexpr (!ALIGN_EPI) { if (wr == 0) PG8_BAR; }
    PG8_BAR;
#undef PG8_SA
#undef PG8_SB
#undef PG8_STAGE
#undef PG8_STAGE_A0
#undef PG8_STAGE_A1
#undef PG8_LDA
#undef PG8_LDB
#undef PG8_MMA
#undef PG8_WAIT_V
#undef PG8_WAIT_L
#undef PG8_KITER
#undef PG8_UNIT_HEAD
#undef PG8_UNIT_TAIL
#undef PG8_BAR
#undef PG8_SCHED
}
}

typedef GAS unsigned gu32;
#define RLX_AGENT __ATOMIC_RELAXED, __HIP_MEMORY_SCOPE_AGENT
#define XB_TMO      128
#define XB_XCNT(j)  (256  + 64 * (j))
#define XB_XSUB(j)  (1280 + 64 * (j))
#define XB_XGEN(j)  (2304 + 64 * (j))
#define XB_TOP      3328
#define XB_TOPGEN   3392
#define XCD_BAR_WORDS 3456
#define XB_SPIN_CAP (1u << 20)
__device__ __forceinline__ unsigned xb_ld(unsigned* p)              { return __hip_atomic_load(p, __ATOMIC_RELAXED, __HIP_MEMORY_SCOPE_AGENT); }
__device__ __forceinline__ unsigned xb_add(unsigned* p, unsigned v) { return __hip_atomic_fetch_add(p, v, __ATOMIC_RELAXED, __HIP_MEMORY_SCOPE_AGENT); }
__device__ __forceinline__ unsigned xb_xcc_id() { return (unsigned)__builtin_amdgcn_s_getreg((3 << 11) | 20) & 0xFu; }
#define XB_SPIN(cond, bar) do { unsigned _sp = 0; while (cond) { __builtin_amdgcn_s_sleep(1); \
    if ((++_sp & 255u) == 0u) { if (xb_ld(&(bar)[XB_TMO])) break; if (_sp > XB_SPIN_CAP) { atomicAdd(&(bar)[XB_TMO], 1u); break; } } } } while (0)
struct XcdBarrier { unsigned* bar; unsigned x; volatile LAS unsigned* st; };
__device__ __forceinline__ XcdBarrier xcd_barrier_post(unsigned* bar, volatile LAS unsigned* st) {
    XcdBarrier b; b.bar = bar; b.x = xb_xcc_id(); b.st = st;
    if (threadIdx.x == 0) (void)xb_add(&bar[XB_XCNT(b.x)], 1u);
    return b;
}
__device__ __forceinline__ void xcd_barrier_complete(unsigned* bar, unsigned x, unsigned& nloc, unsigned& nx) {
    const unsigned G = gridDim.x * gridDim.y * gridDim.z;
    unsigned sum, cnt, mine, sp = 0u;
    for (;;) {
        sum = 0u; cnt = 0u; mine = 0u;
#pragma unroll
        for (unsigned j = 0; j < 16; ++j) { const unsigned c = xb_ld(&bar[XB_XCNT(j)]); sum += c; cnt += (c > 0u) ? 1u : 0u; mine = (j == x) ? c : mine; }
        if (sum == G) break;
        __builtin_amdgcn_s_sleep(1);
        if ((++sp & 255u) == 0u) { if (xb_ld(&bar[XB_TMO])) break; if (sp > XB_SPIN_CAP) { atomicAdd(&bar[XB_TMO], 1u); break; } }
    }
    nloc = mine > 0u ? mine : 1u; nx = cnt > 0u ? cnt : 1u;
}
__device__ __forceinline__ void xcd_barrier(const XcdBarrier& b, const int tid) {
    asm volatile("s_waitcnt vmcnt(0)" ::: "memory");
    __syncthreads();
    if (tid == 0) {
        unsigned* bar = b.bar;
        __builtin_amdgcn_s_waitcnt(0);
        unsigned nloc = b.st[0], nx = b.st[1];
        if (nloc == 0u) { xcd_barrier_complete(bar, b.x, nloc, nx); b.st[0] = nloc; b.st[1] = nx; }
        const unsigned old = xb_add(&bar[XB_XSUB(b.x)], 1u);
        const unsigned gen = old / nloc;
        if (old + 1u == (gen + 1u) * nloc) {
            __builtin_amdgcn_fence(__ATOMIC_RELEASE, "agent");
            asm volatile("s_waitcnt vmcnt(0)" ::: "memory");
            const unsigned og = xb_add(&bar[XB_TOP], 1u);
            const unsigned tg = og / nx;
            if (og + 1u == (tg + 1u) * nx) xb_add(&bar[XB_TOPGEN], 1u);
            else XB_SPIN(xb_ld(&bar[XB_TOPGEN]) == tg, bar);
            __builtin_amdgcn_fence(__ATOMIC_ACQUIRE, "agent");
            xb_add(&bar[XB_XGEN(b.x)], 1u);
            asm volatile("s_waitcnt vmcnt(0)" ::: "memory");
        } else {
            XB_SPIN(xb_ld(&bar[XB_XGEN(b.x)]) == gen, bar);
            __builtin_amdgcn_fence(__ATOMIC_ACQUIRE, "agent");
            asm volatile("s_waitcnt vmcnt(0)" ::: "memory");
        }
    }
    __syncthreads();
}

struct Args {
    const float* x; const int* pos; const float* norm_mix; const float* norm_ffn; const float* norm_final;
    const float* conv_w_in; const float* conv_w; const float* conv_w_out; const float* attn_w_qkv; const float* attn_w_o;
    const float* w_coarse; const float* b_coarse; const float* w_fine; const float* b_fine; const float* w_gate; const float* w_up; const float* w_down;
    float* out; unsigned char* ws; int ph_lo, ph_hi;
};

__constant__ double INVREV[32] = {0.15915494309189535, 0.11934937021124886, 0.08949940160889101, 0.06711508300522726, 0.050329212104487035, 0.03774158471741977, 0.0283021958306234, 0.02122365276477766,
    0.015915494309189534, 0.011934937021124886, 0.008949940160889102, 0.006711508300522725, 0.005032921210448704, 0.003774158471741977, 0.00283021958306234, 0.0021223652764777662,
    0.0015915494309189536, 0.0011934937021124885, 0.0008949940160889102, 0.0006711508300522726, 0.0005032921210448703, 0.00037741584717419774, 0.00028302195830623395, 0.0002122365276477766,
    0.00015915494309189535, 0.00011934937021124886, 8.949940160889102e-05, 6.711508300522725e-05, 5.0329212104487035e-05, 3.774158471741978e-05, 2.8302195830623396e-05, 2.122365276477766e-05};

__device__ __forceinline__ int dest_row(int mode, int n0) {
    switch (mode) {
        default: return n0;
        case 1: { const int s = n0 >> 10, j = n0 & 1023; if (s == 0) return j; const int q = j >> 7; return 1024 + 256 * q + (s == 2 ? 128 : 0) + (j & 127); }
        case 2: { const int sec = n0 >> 10, j = n0 & 1023, head = j >> 6, d = j & 63, tile = head >> 2, hit = head & 3, bj = d >> 5, dd = d & 31; return sec * 1024 + tile * 256 + bj * 128 + hit * 32 + dd; }
        case 3: { const int pn = n0 >> 7; return 256 * pn + (n0 & 127); }
        case 4: { const int pn = n0 >> 7; return 256 * pn + 128 + (n0 & 127); }
    }
}
__device__ __forceinline__ void transpose_item(const float* W, int K, int N, bf16_t* WT, int mode, LAS float* scr, int item, int lane, const float* ksc = nullptr) {
    const int nblk = N / 64, kb = item / nblk, nb = item % nblk, k0 = 64 * kb, n0 = 64 * nb;
    const float nsc = (mode == 2 && ((n0 >> 10) % 3) == 0) ? C2 : 1.f;
#pragma unroll
    for (int hblk = 0; hblk < 2; ++hblk) {
        f32x4 v[8];
#pragma unroll
        for (int i = 0; i < 8; ++i) { const int kk = 4 * (8 * hblk + i) + (lane >> 4), nn = 4 * (lane & 15); v[i] = *(const f32x4*)(W + (size_t)(k0 + kk) * N + n0 + nn); }
        __builtin_amdgcn_sched_barrier(0);
#pragma unroll
        for (int i = 0; i < 8; ++i) { const int kk = 4 * (8 * hblk + i) + (lane >> 4), nn = 4 * (lane & 15); f32x4 w = v[i];
            if (ksc) w *= ksc[k0 + kk];
            w *= nsc;
            LAS float* s = scr + kk * 65 + nn; s[0] = w[0]; s[1] = w[1]; s[2] = w[2]; s[3] = w[3]; }
    }
    LDS_WAIT(); asm volatile("" ::: "memory");
    const int c = lane & 7;
#pragma unroll
    for (int j = 0; j < 8; ++j) { const int n = (lane >> 3) + 8 * j; const LAS float* s = scr + (8 * c) * 65 + n;
        u32x4 o; o.x = cvtpk(s[0 * 65], s[1 * 65]); o.y = cvtpk(s[2 * 65], s[3 * 65]); o.z = cvtpk(s[4 * 65], s[5 * 65]); o.w = cvtpk(s[6 * 65], s[7 * 65]);
        const int dr = dest_row(mode, n0 + (n & 32)) + (n & 31);
        *(u32x4*)(WT + (size_t)dr * K + k0 + 8 * c) = o; }
    LDS_WAIT(); asm volatile("" ::: "memory");
}

__device__ __forceinline__ void unpack8(const u32x4 t, float (&f)[8]) { f[0] = bflo(t.x); f[1] = bfhi(t.x); f[2] = bflo(t.y); f[3] = bfhi(t.y); f[4] = bflo(t.z); f[5] = bfhi(t.z); f[6] = bflo(t.w); f[7] = bfhi(t.w); }
__device__ __forceinline__ u32x4 pack8(const float (&f)[8]) { u32x4 w; w.x = cvtpk(f[0], f[1]); w.y = cvtpk(f[2], f[3]); w.z = cvtpk(f[4], f[5]); w.w = cvtpk(f[6], f[7]); return w; }
template <int MODE>
__device__ __forceinline__ void norm_rows(const float* x, bf16_t* h, float* out, const bf16_t* YS, const float* gw, bf16_t* HN, int gw_id, int lane, bool dummy) {
    float gv[2][8];
#pragma unroll
    for (int j = 0; j < 2; ++j) { const f32x4 a = *(const f32x4*)(gw + 8 * lane + 512 * j), b = *(const f32x4*)(gw + 8 * lane + 512 * j + 4);
#pragma unroll
        for (int i = 0; i < 4; ++i) { gv[j][i] = a[i]; gv[j][4 + i] = b[i]; } }
    f32x4 xa[2][2], nxa[2][2]; u32x4 hh[2], ya[2], yb[2], nhh[2], nya[2], nyb[2];
#define NR_LOAD(X, H, A, B, row) do { \
        if (MODE == 0) { const float* xr_ = x + (size_t)(row) * DM + 8 * lane; _Pragma("unroll") for (int j = 0; j < 2; ++j) { X[j][0] = *(const f32x4*)(xr_ + 512 * j); X[j][1] = *(const f32x4*)(xr_ + 512 * j + 4); } } \
        else { const bf16_t* hr_ = h + (size_t)(row) * HP + 8 * lane; const bf16_t* y0_ = YS + (size_t)(2 * (row)) * DM + 8 * lane; \
            _Pragma("unroll") for (int j = 0; j < 2; ++j) { H[j] = *(const u32x4*)(hr_ + 512 * j); A[j] = *(const u32x4*)(y0_ + 512 * j); B[j] = *(const u32x4*)(y0_ + DM + 512 * j); } } } while (0)
    NR_LOAD(xa, hh, ya, yb, gw_id * 16);
    for (int rr = 0; rr < 16; ++rr) {
        const int row = gw_id * 16 + rr;
        if (rr < 15) NR_LOAD(nxa, nhh, nya, nyb, row + 1);
        float v[2][8];
        if (MODE == 0) {
#pragma unroll
            for (int j = 0; j < 2; ++j)
#pragma unroll
                for (int i = 0; i < 4; ++i) { v[j][i] = xa[j][0][i]; v[j][4 + i] = xa[j][1][i]; }
        } else {
#pragma unroll
            for (int j = 0; j < 2; ++j) { float a[8], b[8]; unpack8(hh[j], v[j]); unpack8(ya[j], a); unpack8(yb[j], b);
                if (!dummy) {
#pragma unroll
                    for (int i = 0; i < 8; ++i) v[j][i] += a[i] + b[i]; } }
        }
        float s = 0.f;
#pragma unroll
        for (int j = 0; j < 2; ++j)
#pragma unroll
            for (int i = 0; i < 8; ++i) s += v[j][i] * v[j][i];
        const float rstd = 1.0f / sqrtf(wave_sum(s) * (1.f / DM) + EPS);
        if (MODE == 1) {
#pragma unroll
            for (int j = 0; j < 2; ++j) *(u32x4*)(h + (size_t)row * HP + 8 * lane + 512 * j) = pack8(v[j]); }
#pragma unroll
        for (int j = 0; j < 2; ++j)
#pragma unroll
            for (int i = 0; i < 8; ++i) v[j][i] *= rstd * gv[j][i];
        if (MODE == 2) {
#pragma unroll
            for (int j = 0; j < 2; ++j) { float* o = out + (size_t)row * DM + 8 * lane + 512 * j; *(f32x4*)o = (f32x4){v[j][0], v[j][1], v[j][2], v[j][3]}; *(f32x4*)(o + 4) = (f32x4){v[j][4], v[j][5], v[j][6], v[j][7]}; } }
        else {
#pragma unroll
            for (int j = 0; j < 2; ++j) *(u32x4*)(HN + (size_t)row * DM + 8 * lane + 512 * j) = pack8(v[j]); }
#pragma unroll
        for (int j = 0; j < 2; ++j) { xa[j][0] = nxa[j][0]; xa[j][1] = nxa[j][1]; hh[j] = nhh[j]; ya[j] = nya[j]; yb[j] = nyb[j]; }
    }
#undef NR_LOAD
}

constexpr int RT_WC = 0, RT_WF = 16384, RT_CNT = 81920, RT_BASE = RT_CNT + 64, RT_INFO = RT_BASE + 64;
__device__ __forceinline__ void route_phase(LAS unsigned char* lds, const bf16_t* h, const float* gw, bf16_t* HN, const float* w_coarse, const float* b_coarse, const float* w_fine, const float* b_fine,
                                            unsigned* gcnt, int* list, float* gate, float* rsc, int gw_id, int wave, int lane, int tid, bool dummy) {
    LAS f32x4* wcL = (LAS f32x4*)(lds + RT_WC); LAS f32x4* wfL = (LAS f32x4*)(lds + RT_WF);
    LAS int* cntL = (LAS int*)(lds + RT_CNT); LAS int* baseL = (LAS int*)(lds + RT_BASE); LAS int* info = (LAS int*)(lds + RT_INFO);
    for (int k = tid; k < 1024; k += 512) { const int l = (k & 511) >> 3, j = k >> 9, i = k & 7; wcL[(j * 8 + i) * 64 + l] = *(const f32x4*)(w_coarse + 4 * k);
#pragma unroll
        for (int g = 0; g < 4; ++g) wfL[g * 1024 + (j * 8 + i) * 64 + l] = *(const f32x4*)(w_fine + (size_t)g * 4096 + 4 * k); }
    if (tid < 16) cntL[tid] = 0;
    __syncthreads();
    float gv[2][8];
#pragma unroll
    for (int j = 0; j < 2; ++j) { const f32x4 a = *(const f32x4*)(gw + 8 * lane + 512 * j), b = *(const f32x4*)(gw + 8 * lane + 512 * j + 4);
#pragma unroll
        for (int i = 0; i < 4; ++i) { gv[j][i] = a[i]; gv[j][4 + i] = b[i]; } }
    const f32x4 bc = *(const f32x4*)b_coarse;
    u32x4 dd[2], ndd[2];
#define RT_LOAD(DD, row) do { const bf16_t* dr_ = h + (size_t)(row) * HP + 8 * lane; DD[0] = *(const u32x4*)dr_; DD[1] = *(const u32x4*)(dr_ + 512); } while (0)
    RT_LOAD(dd, gw_id * 16);
    for (int rr = 0; rr < 16; ++rr) {
        const int row = gw_id * 16 + rr;
        if (rr < 15) RT_LOAD(ndd, row + 1);
        float v[2][8];
        unpack8(dd[0], v[0]); unpack8(dd[1], v[1]);
        float s = 0.f;
#pragma unroll
        for (int j = 0; j < 2; ++j)
#pragma unroll
            for (int i = 0; i < 8; ++i) s += v[j][i] * v[j][i];
        const float rstd = 1.0f / sqrtf(wave_sum(s) * (1.f / DM) + EPS);
#pragma unroll
        for (int j = 0; j < 2; ++j) {
#pragma unroll
            for (int i = 0; i < 8; ++i) v[j][i] *= rstd * gv[j][i]; }
        f32x4 pc = {0.f, 0.f, 0.f, 0.f};
        {
            f32x4 wv[2][8];
#pragma unroll
            for (int j = 0; j < 2; ++j)
#pragma unroll
                for (int i = 0; i < 8; ++i) wv[j][i] = wcL[(j * 8 + i) * 64 + lane];
            __builtin_amdgcn_sched_barrier(0);
#pragma unroll
            for (int j = 0; j < 2; ++j)
#pragma unroll
                for (int i = 0; i < 8; ++i) pc += wv[j][i] * v[j][i];
        }
        float c0 = wave_sum(pc[0]) + bc[0], c1 = wave_sum(pc[1]) + bc[1], c2 = wave_sum(pc[2]) + bc[2], c3 = wave_sum(pc[3]) + bc[3];
        int gt = 0; float cm = c0; if (c1 > cm) { cm = c1; gt = 1; } if (c2 > cm) { cm = c2; gt = 2; } if (c3 > cm) { cm = c3; gt = 3; }
        const float ptop = 1.0f / (__expf(c0 - cm) + __expf(c1 - cm) + __expf(c2 - cm) + __expf(c3 - cm));
        gt = __builtin_amdgcn_readfirstlane(gt);
        f32x4 pf = {0.f, 0.f, 0.f, 0.f};
        const LAS f32x4* wfg = wfL + gt * 1024;
        {
            f32x4 wv[2][8];
#pragma unroll
            for (int j = 0; j < 2; ++j)
#pragma unroll
                for (int i = 0; i < 8; ++i) wv[j][i] = wfg[(j * 8 + i) * 64 + lane];
            __builtin_amdgcn_sched_barrier(0);
#pragma unroll
            for (int j = 0; j < 2; ++j)
#pragma unroll
                for (int i = 0; i < 8; ++i) pf += wv[j][i] * v[j][i];
        }
        const f32x4 bf = *(const f32x4*)(b_fine + 4 * gt);
        float f[4]; f[0] = wave_sum(pf[0]) + bf[0]; f[1] = wave_sum(pf[1]) + bf[1]; f[2] = wave_sum(pf[2]) + bf[2]; f[3] = wave_sum(pf[3]) + bf[3];
        int i0 = 0; float m0 = f[0];
#pragma unroll
        for (int i = 1; i < 4; ++i) if (f[i] > m0) { m0 = f[i]; i0 = i; }
        int i1 = -1; float m1 = -INFINITY;
#pragma unroll
        for (int i = 0; i < 4; ++i) if (i != i0 && f[i] > m1) { m1 = f[i]; i1 = i; }
        const float ex = __expf(m1 - m0), den = 1.0f / (1.0f + ex);
        const float g0 = ptop * den, g1 = ptop * ex * den;
        if (lane == 0) { const int e0 = gt * 4 + i0, e1 = gt * 4 + i1;
            const int p0 = __hip_atomic_fetch_add(&cntL[e0], 1, __ATOMIC_RELAXED, __HIP_MEMORY_SCOPE_WORKGROUP);
            const int p1 = __hip_atomic_fetch_add(&cntL[e1], 1, __ATOMIC_RELAXED, __HIP_MEMORY_SCOPE_WORKGROUP);
            LAS int* inf = info + (wave * 16 + rr) * 8; inf[0] = e0; inf[1] = p0; inf[2] = __float_as_int(g0); inf[3] = e1; inf[4] = p1; inf[5] = __float_as_int(g1); inf[6] = row; inf[7] = __float_as_int(rstd); }
        dd[0] = ndd[0]; dd[1] = ndd[1];
    }
#undef RT_LOAD
    __syncthreads();
    if (tid < 16) baseL[tid] = dummy ? 0 : (int)__hip_atomic_fetch_add(gcnt + tid, (unsigned)cntL[tid], __ATOMIC_RELAXED, __HIP_MEMORY_SCOPE_AGENT);
    __syncthreads();
    if (tid < 128 && !dummy) { const LAS int* inf = info + tid * 8; const int e0 = inf[0], e1 = inf[3], row = inf[6];
        const int q0 = baseL[e0] + inf[1], q1 = baseL[e1] + inf[4];
        list[e0 * 32768 + q0] = row * 2; gate[e0 * 32768 + q0] = __int_as_float(inf[2]); rsc[e0 * 32768 + q0] = __int_as_float(inf[7]);
        list[e1 * 32768 + q1] = row * 2 + 1; gate[e1 * 32768 + q1] = __int_as_float(inf[5]); rsc[e1 * 32768 + q1] = __int_as_float(inf[7]); }
    __syncthreads();
}

constexpr int RM_CNT = 131072, RM_BASE = RM_CNT + 64, RM_INFO = RM_BASE + 64, RM_BF = RM_INFO + 4096;
static_assert(RM_BF + 64 <= RING_BYTES, "router LDS map");
__device__ __forceinline__ void router_image_to_lds(LAS unsigned char* lds, const unsigned char* rimg, int wave, int lane) {
    for (int pc = wave; pc < 128; pc += 8) __builtin_amdgcn_global_load_lds((const unsigned*)(rimg + pc * 1024 + lane * 16), (LAS unsigned*)(lds + pc * 1024), 16, 0, 0);
}
__device__ __forceinline__ float lane_fetch(int src_lane, float v) { return __int_as_float(__builtin_amdgcn_ds_bpermute(src_lane << 2, __float_as_int(v))); }
__device__ __forceinline__ void route_phase_mfma(LAS unsigned char* lds, const bf16_t* h, const unsigned char* rimg, const float* b_coarse, const float* b_fine,
                                                 unsigned* gcnt, int* list, float* gate, float* rsc, int gw_id, int wave, int lane, int tid, bool dummy, bool img_ready) {
    LAS int* cntL = (LAS int*)(lds + RM_CNT); LAS int* baseL = (LAS int*)(lds + RM_BASE); LAS int* info = (LAS int*)(lds + RM_INFO); LAS float* bfL = (LAS float*)(lds + RM_BF);
    if (!img_ready) router_image_to_lds(lds, rimg, wave, lane);
    if (tid < 16) { cntL[tid] = 0; bfL[tid] = b_fine[tid]; }
    const int r = lane & 15, q = lane >> 4;
    const bf16_t* hp = h + (size_t)(gw_id * 16 + r) * HP + 8 * q;
    bf16x8 hf[2][8];
#pragma unroll
    for (int i = 0; i < 8; ++i) hf[0][i] = *(const bf16x8*)(hp + 32 * i);
    const f32x4 bc = *(const f32x4*)b_coarse;
    asm volatile("s_waitcnt vmcnt(0)" ::: "memory");
    __syncthreads();
    f32x4 acc0 = {0.f, 0.f, 0.f, 0.f}, acc1 = {0.f, 0.f, 0.f, 0.f}, gram = {0.f, 0.f, 0.f, 0.f};
#pragma unroll
    for (int b = 0; b < 4; ++b) {
        if (b + 1 < 4) {
#pragma unroll
            for (int i = 0; i < 8; ++i) hf[(b + 1) & 1][i] = *(const bf16x8*)(hp + 32 * (8 * (b + 1) + i)); }
        __builtin_amdgcn_sched_barrier(0);
#pragma unroll
        for (int i = 0; i < 8; ++i) { const LAS char* wp = (const LAS char*)lds + (8 * b + i) * 4096 + lane * 16;
            const bf16x8 w00 = *(const LAS bf16x8*)wp, w01 = *(const LAS bf16x8*)(wp + 1024), w10 = *(const LAS bf16x8*)(wp + 2048), w11 = *(const LAS bf16x8*)(wp + 3072), hv = hf[b & 1][i];
            acc0 = __builtin_amdgcn_mfma_f32_16x16x32_bf16(w00, hv, acc0, 0, 0, 0); acc0 = __builtin_amdgcn_mfma_f32_16x16x32_bf16(w01, hv, acc0, 0, 0, 0);
            acc1 = __builtin_amdgcn_mfma_f32_16x16x32_bf16(w10, hv, acc1, 0, 0, 0); acc1 = __builtin_amdgcn_mfma_f32_16x16x32_bf16(w11, hv, acc1, 0, 0, 0);
            gram = __builtin_amdgcn_mfma_f32_16x16x32_bf16(hv, hv, gram, 0, 0, 0); }
    }
    const int ri = r & 3; const float gsel = ri == 0 ? gram[0] : ri == 1 ? gram[1] : ri == 2 ? gram[2] : gram[3];
    const float ss = lane_fetch(r + 16 * (r >> 2), gsel);
    const float rstd = 1.0f / sqrtf(ss * (1.f / DM) + EPS);
    const float c0 = acc0[0] * rstd + bc[0], c1 = acc0[1] * rstd + bc[1], c2 = acc0[2] * rstd + bc[2], c3 = acc0[3] * rstd + bc[3];
    int gt = 0; float cm = c0; if (c1 > cm) { cm = c1; gt = 1; } if (c2 > cm) { cm = c2; gt = 2; } if (c3 > cm) { cm = c3; gt = 3; }
    const float ptop = 1.0f / (__expf(c0 - cm) + __expf(c1 - cm) + __expf(c2 - cm) + __expf(c3 - cm));
    const int fs = r + 16 * ((gt + 1) & 3);
    float f[4];
#pragma unroll
    for (int i = 0; i < 4; ++i) { const float o = lane_fetch(fs, acc0[i]); f[i] = (gt == 3 ? acc1[i] : o) * rstd + bfL[4 * gt + i]; }
    int i0 = 0; float m0 = f[0];
#pragma unroll
    for (int i = 1; i < 4; ++i) if (f[i] > m0) { m0 = f[i]; i0 = i; }
    int i1 = -1; float m1 = -INFINITY;
#pragma unroll
    for (int i = 0; i < 4; ++i) if (i != i0 && f[i] > m1) { m1 = f[i]; i1 = i; }
    const float ex = __expf(m1 - m0), den = 1.0f / (1.0f + ex);
    const float g0 = ptop * den, g1 = ptop * ex * den;
    if (q == 0) { const int e0 = gt * 4 + i0, e1 = gt * 4 + i1;
        const int p0 = __hip_atomic_fetch_add(&cntL[e0], 1, __ATOMIC_RELAXED, __HIP_MEMORY_SCOPE_WORKGROUP);
        const int p1 = __hip_atomic_fetch_add(&cntL[e1], 1, __ATOMIC_RELAXED, __HIP_MEMORY_SCOPE_WORKGROUP);
        LAS int* inf = info + (wave * 16 + r) * 8; inf[0] = e0; inf[1] = p0; inf[2] = __float_as_int(g0); inf[3] = e1; inf[4] = p1; inf[5] = __float_as_int(g1); inf[6] = gw_id * 16 + r; inf[7] = __float_as_int(rstd); }
    __syncthreads();
    if (tid < 16) baseL[tid] = dummy ? 0 : (int)__hip_atomic_fetch_add(gcnt + tid, (unsigned)cntL[tid], __ATOMIC_RELAXED, __HIP_MEMORY_SCOPE_AGENT);
    __syncthreads();
    if (tid < 128 && !dummy) { const LAS int* inf = info + tid * 8; const int e0 = inf[0], e1 = inf[3], row = inf[6];
        const int q0 = baseL[e0] + inf[1], q1 = baseL[e1] + inf[4];
        list[e0 * 32768 + q0] = row * 2; gate[e0 * 32768 + q0] = __int_as_float(inf[2]); rsc[e0 * 32768 + q0] = __int_as_float(inf[7]);
        list[e1 * 32768 + q1] = row * 2 + 1; gate[e1 * 32768 + q1] = __int_as_float(inf[5]); rsc[e1 * 32768 + q1] = __int_as_float(inf[7]); }
    __syncthreads();
}
__device__ __forceinline__ void router_image_entry(const float* w_coarse, const float* w_fine, const float* norm_ffn, unsigned char* rimg, int en) {
    const int Lr = en >> 13, p = (en >> 6) & 127, l = en & 63, hl = p & 1, t = (p >> 1) & 1, st = p >> 2, m = l & 15, kq = l >> 4, col = 16 * t + m;
    unsigned w[4];
#pragma unroll
    for (int j2 = 0; j2 < 4; ++j2) { float v[2];
#pragma unroll
        for (int x = 0; x < 2; ++x) { const int k = 32 * st + 8 * kq + 2 * j2 + x;
            const float wv = col < 4 ? w_coarse[(size_t)Lr * 4096 + k * 4 + col] : col < 20 ? w_fine[(size_t)Lr * 16384 + ((col - 4) >> 2) * 4096 + k * 4 + ((col - 4) & 3)] : 0.f;
            v[x] = wv * norm_ffn[Lr * DM + k]; }
        const unsigned hi = cvtpk(v[0], v[1]);
        w[j2] = hl == 0 ? hi : cvtpk(v[0] - __uint_as_float(hi << 16), v[1] - __uint_as_float(hi & 0xffff0000u)); }
    *(u32x4*)(rimg + (size_t)en * 16) = (u32x4){w[0], w[1], w[2], w[3]};
}

__device__ __forceinline__ void conv_phase(const bf16_t* Bg, const bf16_t* U, bf16_t* Y, const float* cw  , int gw_id, int lane) {
    const int rb = gw_id >> 1, c0 = (gw_id & 1) * 512 + lane * 8, t0 = rb * 32;
    float w0[8], w1[8], w2[8];
#pragma unroll
    for (int i = 0; i < 8; ++i) { w0[i] = cw[c0 + i]; w1[i] = cw[1024 + c0 + i]; w2[i] = cw[2048 + c0 + i]; }
    float um1[8], um2[8];
    const bool hasprev = (t0 & (SEQ - 1)) != 0;
    { u32x4 a = {0u, 0u, 0u, 0u}, b = {0u, 0u, 0u, 0u};
      if (hasprev) { a = *(const u32x4*)(U + (size_t)(t0 - 1) * DM + c0); b = *(const u32x4*)(U + (size_t)(t0 - 2) * DM + c0); }
#pragma unroll
      for (int i = 0; i < 4; ++i) { um1[2 * i] = bflo(a[i]); um1[2 * i + 1] = bfhi(a[i]); um2[2 * i] = bflo(b[i]); um2[2 * i + 1] = bfhi(b[i]); } }
#pragma unroll 4
    for (int t = 0; t < 32; ++t) {
        const u32x4 uu = *(const u32x4*)(U + (size_t)(t0 + t) * DM + c0), bb = *(const u32x4*)(Bg + (size_t)(t0 + t) * DM + c0);
        float uc[8], bg[8], y[8];
#pragma unroll
        for (int i = 0; i < 4; ++i) { uc[2 * i] = bflo(uu[i]); uc[2 * i + 1] = bfhi(uu[i]); bg[2 * i] = bflo(bb[i]); bg[2 * i + 1] = bfhi(bb[i]); }
#pragma unroll
        for (int i = 0; i < 8; ++i) { y[i] = bg[i] * (w0[i] * um2[i] + w1[i] * um1[i] + w2[i] * uc[i]); um2[i] = um1[i]; um1[i] = uc[i]; }
        u32x4 o; o.x = cvtpk(y[0], y[1]); o.y = cvtpk(y[2], y[3]); o.z = cvtpk(y[4], y[5]); o.w = cvtpk(y[6], y[7]);
        *(u32x4*)(Y + (size_t)(t0 + t) * DM + c0) = o;
    }
}

__device__ __forceinline__ int crow(int r, int hi) { return (r & 3) + 8 * (r >> 2) + 4 * hi; }
__device__ __forceinline__ s16x4 vtr(const LAS char* p) { typedef short v4i16_t __attribute__((ext_vector_type(4))); return __builtin_bit_cast(s16x4, __builtin_amdgcn_ds_read_tr16_b64_v4i16((LAS v4i16_t*)p)); }
template <bool MERGE>
__device__ __forceinline__ void attn_wave_unit(bf16_t* QKVh, int b, int h, int g, int r, int a0, int sh, const LAS char* Kst, const LAS char* Vst, int sub0, LAS char* ks, LAS float* wsf, float* lseG, int tl0, int lane, bool dummy,
                                               const u32x4 (&qreg)[4], const float* lse01, bf16_t* Oh, int tokbase) {
    const int r32 = lane & 31, hi = lane >> 5, lrow = lane >> 3, lch = lane & 7;
    bf16_t* base = QKVh + ((size_t)(g * 12 + (h >> 2)) * TSZ + (size_t)(b * SEQ + r) * QP + (h & 3) * 64);
    const unsigned rs = (unsigned)QP << sh;
    const int jmin = a0 >= 128 ? 0 : 4 - (a0 >> 5);
    u32x4 o0reg[4], o1reg[4]; float la[4], lb[4];
    const int kwoff = lrow * 128 + ((lch ^ lrow) * 16);
    const int kroff = r32 * 128;
    bf16x8 qr[4];
#pragma unroll
    for (int p = 0; p < 4; ++p) *(LAS u32x4*)(ks + kwoff + p * 1024) = qreg[p];
#pragma unroll
    for (int d0 = 0; d0 < 4; ++d0) qr[d0] = *(const LAS bf16x8*)(ks + kroff + (((2 * d0 + hi) ^ (r32 & 7)) * 16));
    f32x16 s[5];
    {
        bf16x8 kf[2][4];
#define AT_LDK(buf, j) do { const int sj_ = sub0 + (j) < 0 ? 0 : sub0 + (j); const LAS char* kj_ = Kst + sj_ * 4096; \
            _Pragma("unroll") for (int d0 = 0; d0 < 4; ++d0) kf[buf][d0] = *(const LAS bf16x8*)(kj_ + kroff + (((2 * d0 + hi) ^ (r32 & 7)) * 16)); } while (0)
        AT_LDK(0, 0);
#pragma unroll
        for (int j = 0; j < 5; ++j) {
            if (j + 1 < 5) AT_LDK((j + 1) & 1, j + 1);
            __builtin_amdgcn_sched_barrier(0);
            f32x16 a = {0.f, 0.f, 0.f, 0.f, 0.f, 0.f, 0.f, 0.f, 0.f, 0.f, 0.f, 0.f, 0.f, 0.f, 0.f, 0.f};
#pragma unroll
            for (int d0 = 0; d0 < 4; ++d0) a = __builtin_amdgcn_mfma_f32_32x32x16_bf16(kf[j & 1][d0], qr[d0], a, 0, 0, 0);
            s[j] = a;
        }
#undef AT_LDK
    }
    if (jmin > 0) {
#pragma unroll
        for (int j = 0; j < 4; ++j) { if (j < jmin) {
#pragma unroll
            for (int q = 0; q < 16; ++q) s[j][q] = -INFINITY; } }
    }
    if (MERGE) {
        asm volatile("" ::: "memory");
        const bf16_t* ob = QKVh + ((size_t)(h >> 2) * TSZ + (size_t)tokbase * QP + (h & 3) * 64 + lch * 8);
#pragma unroll
        for (int i = 0; i < 4; ++i) { const unsigned tl = (unsigned)(tl0 + ((8 * i + lrow) << sh)); const unsigned off = tl * (unsigned)QP; o0reg[i] = *(const u32x4*)(ob + off); o1reg[i] = *(const u32x4*)(ob + (off + 12u * (unsigned)TSZ));
            la[i] = lse01[(size_t)(tokbase + tl) * 16 + h]; lb[i] = lse01[(size_t)(HTOK + tokbase + tl) * 16 + h]; }
    }
#pragma unroll
    for (int q = 0; q < 16; ++q) { const int cr = crow(q, hi); if (cr < r32) s[0][q] = -INFINITY; if (cr > r32) s[4][q] = -INFINITY; }
    float mx;
    { float m4[4] = {-INFINITY, -INFINITY, -INFINITY, -INFINITY};
#pragma unroll
      for (int j = 0; j < 5; ++j)
#pragma unroll
          for (int q = 0; q < 16; ++q) m4[q & 3] = fmaxf(m4[q & 3], s[j][q]);
      mx = fmaxf(fmaxf(m4[0], m4[1]), fmaxf(m4[2], m4[3])); }
    { auto rr = __builtin_amdgcn_permlane32_swap(__float_as_uint(mx), __float_as_uint(mx), false, false); mx = fmaxf(__uint_as_float(rr[0]), __uint_as_float(rr[1])); }
    float l4[4] = {0.f, 0.f, 0.f, 0.f};
    u32x4 pw[5][2];
#pragma unroll
    for (int j = 0; j < 5; ++j) {
#pragma unroll
        for (int q = 0; q < 16; ++q) { s[j][q] = __builtin_amdgcn_exp2f(s[j][q] - mx); l4[q & 3] += s[j][q]; }
        pw[j][0] = (u32x4){cvtpk(s[j][0], s[j][1]), cvtpk(s[j][2], s[j][3]), cvtpk(s[j][4], s[j][5]), cvtpk(s[j][6], s[j][7])};
        pw[j][1] = (u32x4){cvtpk(s[j][8], s[j][9]), cvtpk(s[j][10], s[j][11]), cvtpk(s[j][12], s[j][13]), cvtpk(s[j][14], s[j][15])};
    }
    float l = (l4[0] + l4[1]) + (l4[2] + l4[3]);
    { auto rr = __builtin_amdgcn_permlane32_swap(__float_as_uint(l), __float_as_uint(l), false, false); l = __uint_as_float(rr[0]) + __uint_as_float(rr[1]); }
    f32x16 o[2];
#pragma unroll
    for (int q = 0; q < 16; ++q) { o[0][q] = 0.f; o[1][q] = 0.f; }
    const int vroff = ((lane >> 4) & 1) * 32 + (lane & 3) * 8 + (4 * hi + ((lane & 15) >> 2)) * 64;
    {
        bf16x8 vf[2][2][2];
#define AT_LDV(buf, j) do { const int sj_ = sub0 + (j) < 0 ? 0 : sub0 + (j); const LAS char* vp_ = Vst + sj_ * 4096 + vroff; \
            _Pragma("unroll") for (int ks2 = 0; ks2 < 2; ++ks2) _Pragma("unroll") for (int d0 = 0; d0 < 2; ++d0) { const s16x4 lo_ = vtr(vp_ + d0 * 2048 + ks2 * 1024), hh_ = vtr(vp_ + d0 * 2048 + ks2 * 1024 + 512); \
                vf[buf][ks2][d0] = (bf16x8){lo_[0], lo_[1], lo_[2], lo_[3], hh_[0], hh_[1], hh_[2], hh_[3]}; } } while (0)
        AT_LDV(0, 0);
#pragma unroll
        for (int j = 0; j < 5; ++j) {
            if (j + 1 < 5) AT_LDV((j + 1) & 1, j + 1);
            __builtin_amdgcn_sched_barrier(0);
#pragma unroll
            for (int ks2 = 0; ks2 < 2; ++ks2)
#pragma unroll
                for (int d0 = 0; d0 < 2; ++d0) o[d0] = __builtin_amdgcn_mfma_f32_32x32x16_bf16(__builtin_bit_cast(bf16x8, pw[j][ks2]), vf[j & 1][ks2][d0], o[d0], 0, 0, 0);
        }
#undef AT_LDV
    }
    LAS bf16_t* stg = (LAS bf16_t*)ks;
    const float lse = mx + __builtin_amdgcn_logf(l);
    if (hi == 0) { wsf[r32] = __builtin_amdgcn_rcpf(l); if (MERGE) wsf[32 + r32] = lse; else lseG[(size_t)(tokbase + tl0 + (r32 << sh)) * 16 + h] = lse; }
#pragma unroll
    for (int q = 0; q < 16; ++q) { const int orow = crow(q, hi); const float rl = wsf[orow];
#pragma unroll
        for (int d0 = 0; d0 < 2; ++d0) { const unsigned pk = cvtpk(o[d0][q] * rl, 0.f); stg[orow * 64 + d0 * 32 + r32] = (bf16_t)(pk & 0xffffu); } }
#pragma unroll
    for (int i = 0; i < 4; ++i) { const int row = i * 8 + lrow; const u32x4 v = *(const LAS u32x4*)(stg + row * 64 + lch * 8);
        if (!MERGE) { if (!dummy) *(u32x4*)(base + ((unsigned)(a0 + row) * rs + (unsigned)(lch * 8))) = v; }
        else {
            const int tl = tl0 + (row << sh);
            const float l0 = la[i], l1 = lb[i], l2 = wsf[32 + row]; (void)tl;
            const float mm = fmaxf(l0, fmaxf(l1, l2));
            float w0 = __builtin_amdgcn_exp2f(l0 - mm), w1 = __builtin_amdgcn_exp2f(l1 - mm), w2 = __builtin_amdgcn_exp2f(l2 - mm);
            const float inv = __builtin_amdgcn_rcpf(w0 + w1 + w2); w0 *= inv; w1 *= inv; w2 *= inv;
            u32x4 res;
#pragma unroll
            for (int k = 0; k < 4; ++k) { const float lo = w0 * bflo(o0reg[i][k]) + w1 * bflo(o1reg[i][k]) + w2 * bflo(v[k]), hh = w0 * bfhi(o0reg[i][k]) + w1 * bfhi(o1reg[i][k]) + w2 * bfhi(v[k]); res[k] = cvtpk(lo, hh); }
            *(u32x4*)(Oh + (size_t)(tokbase + tl) * DM + h * 64 + lch * 8) = res;
        } }
}
__device__ __forceinline__ void ld16_sc1x3(const void* p0, const void* p1, const void* p2, u32x4& a, u32x4& b, u32x4& c) {
    asm volatile("global_load_dwordx4 %0, %3, off sc1\n\tglobal_load_dwordx4 %1, %4, off sc1\n\tglobal_load_dwordx4 %2, %5, off sc1\n\ts_waitcnt vmcnt(0)"
                 : "=&v"(a), "=&v"(b), "=&v"(c) : "v"(p0), "v"(p1), "v"(p2) : "memory");
}
constexpr int AT_KST = 0, AT_VST = 49152, AT_PRIV = 12544, AT_WQ = 100352, AT_WQ_BYTES = 4352, AT_LSE = AT_WQ + 8 * AT_WQ_BYTES;
static_assert(AT_LSE + 12288 <= RING_BYTES, "attention LDS map");
__device__ __forceinline__ void att_win_load(u32x4 (&wreg)[12], const bf16_t* gbase, unsigned rs, int wb, int split, int tid) {
#pragma unroll
    for (int i = 0; i < 12; ++i) { const int pc = i * 512 + tid, kv = pc >= 3072 ? 1 : 0, q = pc - kv * 3072, row = q >> 3, ch = q & 7, res = row >= split ? 1 : 0; int a = wb + row - res * split; a = a < 0 ? 0 : a;
        wreg[i] = *(const u32x4*)(gbase + ((unsigned)a * rs + (unsigned)(res * QP + (1 + kv) * 4 * TSZ + ch * 8))); }
}
__device__ __forceinline__ void att_win_store(const u32x4 (&wreg)[12], LAS char* lds, int tid) {
#pragma unroll
    for (int i = 0; i < 12; ++i) { const int pc = i * 512 + tid, kv = pc >= 3072 ? 1 : 0, q = pc - kv * 3072, row = q >> 3, ch = q & 7, st = row >> 5, rw = row & 31;
        const int off = kv ? (AT_VST + st * 4096 + (ch >> 2) * 2048 + rw * 64 + (ch & 3) * 16) : (AT_KST + st * 4096 + rw * 128 + ((ch ^ (rw & 7)) * 16));
        *(LAS u32x4*)(lds + off) = wreg[i]; }
}
__device__ __forceinline__ void attn_phase_a(LAS unsigned char* ldsu, bf16_t* QKVh, float* LSE, int vcu, int G, int wave, int lane, int tid, bool dummy) {
    LAS char* lds = (LAS char*)ldsu;
    LAS char* wq = lds + AT_WQ + wave * AT_WQ_BYTES; LAS float* wsfS = (LAS float*)(wq + 4096);
    for (int q = vcu; q < 256; q += G) {
        const int b = q >> 6, h = (q >> 2) & 15, span = q & 3;
        u32x4 wreg[12], qn[4];
        for (int R = -1; R < 8; ++R) {
            int tid_l = tid; asm volatile("" : "+v"(tid_l)); const int lane_l = tid_l & 63;
            u32x4 qc[4];
#pragma unroll
            for (int p = 0; p < 4; ++p) qc[p] = qn[p];
            if (R >= 0) { att_win_store(wreg, lds, tid_l); __syncthreads(); }
            if (R + 1 < 8) { const int Rn = R + 1, g2 = Rn >> 2, r2 = g2 ? (Rn & 3) : 0;
                const int A2 = g2 ? span * 256 : span * 1024 + 256 * (Rn & 3);
                const int hs2 = (h + Rn) & 3;
                const bf16_t* gb = QKVh + ((size_t)(g2 * 12 + (h >> 2)) * TSZ + (size_t)(b * SEQ + r2) * QP + hs2 * 64); const unsigned rsq = (unsigned)QP << (2 * g2);
                att_win_load(wreg, gb, rsq, A2 - 128, 384, tid_l);
#pragma unroll
                for (int p = 0; p < 4; ++p) qn[p] = *(const u32x4*)(gb + ((unsigned)(A2 + 32 * wave + 8 * p + (lane_l >> 3)) * rsq + (unsigned)((lane_l & 7) * 8))); }
            if (R >= 0) {
                const int g = R >> 2, sh = 2 * g, r = g ? (R & 3) : 0;
                const int A0 = g ? span * 256 : span * 1024 + 256 * (R & 3);
                const int a0 = A0 + 32 * wave;
                const int tl0 = g == 0 ? (256 * (R & 3) + 32 * wave) : (((32 * wave) << sh) + r);
                attn_wave_unit<false>(QKVh, b, (h & 12) | ((h + R) & 3), g, r, a0, sh, lds + AT_KST, lds + AT_VST, wave, wq, wsfS, LSE + (size_t)g * HTOK * 16, tl0, lane_l, dummy, qc, LSE, nullptr, b * SEQ + span * 1024);
                __syncthreads();
            }
        }
    }
}
__device__ __forceinline__ void att_seq_load(u32x4 (&wreg)[8], const bf16_t* gbase, unsigned rs, int tid) {
#pragma unroll
    for (int i = 0; i < 8; ++i) { const int pc = i * 512 + tid, kv = pc >= 2048 ? 1 : 0, q = pc - kv * 2048, row = q >> 3, ch = q & 7;
        wreg[i] = *(const u32x4*)(gbase + ((unsigned)row * rs + (unsigned)((1 + kv) * 4 * TSZ + ch * 8))); }
}
__device__ __forceinline__ void att_seq_store(const u32x4 (&wreg)[8], LAS char* lds, int tid) {
#pragma unroll
    for (int i = 0; i < 8; ++i) { const int pc = i * 512 + tid, kv = pc >= 2048 ? 1 : 0, q = pc - kv * 2048, row = q >> 3, ch = q & 7, st = row >> 5, rw = row & 31;
        const int off = kv ? (AT_VST + st * 4096 + (ch >> 2) * 2048 + rw * 64 + (ch & 3) * 16) : (AT_KST + st * 4096 + rw * 128 + ((ch ^ (rw & 7)) * 16));
        *(LAS u32x4*)(lds + off) = wreg[i]; }
}
__device__ __forceinline__ void attn_phase_b(LAS unsigned char* ldsu, bf16_t* QKVh, const float* LSE, bf16_t* Oh, int vcu, int G, int wave, int lane, int tid, bool dummy) {
    LAS char* lds = (LAS char*)ldsu;
    LAS char* wq = lds + AT_WQ + wave * AT_WQ_BYTES; LAS float* wsfS = (LAS float*)(wq + 4096);
    const unsigned rs = (unsigned)QP << 4;
    for (int cu = vcu; cu < 256; cu += G) {
        u32x4 wreg[8], qn[4];
        for (int i = -1; i < 4; ++i) {
            int tid_l = tid; asm volatile("" : "+v"(tid_l)); const int lane_l = tid_l & 63;
            u32x4 qc[4];
#pragma unroll
            for (int p = 0; p < 4; ++p) qc[p] = qn[p];
            if (i >= 0) { att_seq_store(wreg, lds, tid_l); __syncthreads(); }
            if (i + 1 < 4) { const int sq = cu * 4 + i + 1, b2 = sq >> 8, h2r = (sq >> 4) & 15, h2 = (h2r & 12) | ((h2r + i + 1) & 3), r2 = sq & 15;
                const bf16_t* gb = QKVh + ((size_t)(24 + (h2 >> 2)) * TSZ + (size_t)(b2 * SEQ + r2) * QP + (h2 & 3) * 64);
                att_seq_load(wreg, gb, rs, tid_l);
#pragma unroll
                for (int p = 0; p < 4; ++p) qn[p] = *(const u32x4*)(gb + ((unsigned)(32 * wave + 8 * p + (lane_l >> 3)) * rs + (unsigned)((lane_l & 7) * 8))); }
            if (i >= 0) { const int sq = cu * 4 + i, b = sq >> 8, hr = (sq >> 4) & 15, h = (hr & 12) | ((hr + i) & 3), r = sq & 15;
                const int a0 = 32 * wave, tl0 = (a0 << 4) + r;
                attn_wave_unit<true>(QKVh, b, h, 2, r, a0, 4, lds + AT_KST, lds + AT_VST, wave - 4, wq, wsfS, nullptr, tl0, lane_l, dummy, qc, LSE, Oh, b * SEQ);
                __syncthreads();
            }
        }
    }
}

constexpr int NWAVES = 8;
#ifndef ONLY_TYPE
#define PH_ON(t) true
#else
#define PH_ON(t) ((t) == ONLY_TYPE)
#endif
enum { T_PRO = 0, T_CIN, T_CONV, T_COUT, T_QKV, T_ATT, T_WO, T_ROUTE, T_MOE1, T_MOE2, T_NORM, T_ATTB };

typedef const __attribute__((address_space(4))) Args* KArgs;
__global__ void __launch_bounds__(NWAVES * 64, 2) hybrid_fwd(Args args_unused) {
    extern __shared__ __attribute__((aligned(16))) unsigned char lds_raw[];
    LAS unsigned char* lds = (LAS unsigned char*)lds_raw;
    volatile LAS unsigned* MISC = (volatile LAS unsigned*)(lds + MISC_OFF);
    LAS int* mtbl = (LAS int*)(lds + LDSCTL_OFF);
    KArgs ap0 = (KArgs)__builtin_amdgcn_kernarg_segment_ptr();
    const int G = gridDim.x; const int bx = blockIdx.x; const int vcu = (G % 8 == 0) ? (bx % 8) * (G / 8) + bx / 8 : bx;
    for (int u = threadIdx.x; u < (LDS_BYTES - LDSCTL_OFF) / 4; u += NWAVES * 64) ((LAS unsigned*)(lds + LDSCTL_OFF))[u] = 0u;
    __syncthreads();
    XcdBarrier bar; bar.bar = (unsigned*)((gu32*)(ap0->ws + WS_CTL) + CW_BAR); bar.x = 0; bar.st = nullptr;
    if (MK_N_LAUNCHES == 1) bar = xcd_barrier_post(bar.bar, MISC + 8);
    const int ph_lo = ap0->ph_lo, ph_hi = ap0->ph_hi;
    const int wave0 = __builtin_amdgcn_readfirstlane(threadIdx.x >> 6);
#if PROBE
    const unsigned long long t_start = __builtin_amdgcn_s_memrealtime();
#endif

    int dupstate = 0;
    for (int ph = ph_lo; ph < ph_hi; ++ph) {
#define TID_NOW(name) unsigned name##_z = 0u; asm volatile("" : "+v"(name##_z)); int name = wave0 * 64 + (int)__builtin_amdgcn_mbcnt_hi(~0u, __builtin_amdgcn_mbcnt_lo(~0u, name##_z)); const int lane = name & 63
        KArgs ap = ap0; asm volatile("" : "+s"(ap));
        int wave = wave0; asm volatile("" : "+s"(wave));
        const int gw_id = vcu * NWAVES + wave, NGW = G * NWAVES;
        unsigned char* ws = ap->ws;
        gu32* ctl = (gu32*)(ws + WS_CTL);
        bf16_t* WCIN = (bf16_t*)(ws + WS_WCIN); bf16_t* WCOUT = (bf16_t*)(ws + WS_WCOUT); bf16_t* WQKV = (bf16_t*)(ws + WS_WQKV); bf16_t* WO = (bf16_t*)(ws + WS_WO);
        bf16_t* WGU = (bf16_t*)(ws + WS_WGU); bf16_t* WDN = (bf16_t*)(ws + WS_WDN); bf16_t* HN = (bf16_t*)(ws + WS_HN);
        unsigned char* R = ws + WS_R;
        int* list = (int*)(ws + WS_LIST); float* gate = (float*)(ws + WS_GATE);
        _Float16* cosT = (_Float16*)(ws + WS_COS); _Float16* sinT = (_Float16*)(ws + WS_SIN);
        int type, L = 0, half = 0;
        if (ph == 0) type = T_PRO;
        else { int p = ph - 1, sub; bool conv;
            if (p < 7) { L = 0; sub = p; conv = true; } else if (p < 18) { L = 1; sub = p - 7; conv = false; } else if (p < 25) { L = 2; sub = p - 18; conv = true; } else { L = 3; sub = p - 25; conv = false; }
            if (conv) { type = sub == 0 ? T_CIN : sub == 1 ? T_CONV : sub == 2 ? T_COUT : sub == 3 ? T_ROUTE : sub == 4 ? T_MOE1 : sub == 5 ? T_MOE2 : T_NORM; }
            else { type = sub == 0 ? T_QKV : sub == 1 ? T_ATT : sub == 2 ? T_ATTB : sub == 3 ? T_QKV : sub == 4 ? T_ATT : sub == 5 ? T_ATTB : sub == 6 ? T_WO : sub == 7 ? T_ROUTE : sub == 8 ? T_MOE1 : sub == 9 ? T_MOE2 : T_NORM; half = (sub >= 3) ? 1 : 0; } }
        const int j2 = L >> 1;
        const bool is_dup = (type == DUP_TYPE || (DUP_TYPE == T_ATT && type == T_ATTB)) && !(type == T_NORM && L == DEPTH - 1);
        const bool dummy = is_dup && dupstate == 0;
        switch (type) {
        case T_PRO: if (PH_ON(T_PRO)) { TID_NOW(tid);
            LAS float* scr = (LAS float*)(lds + wave * 16640);
            constexpr int I0 = 2 * 16 * 48, I1 = 2 * 16 * 16, I2 = 2 * 16 * 144, I3 = 2 * 16 * 16, I4 = 64 * 16 * 8, I5 = 64 * 16 * 8, I6 = 64 * 8 * 16;
            constexpr int NITEMS = I0 + I1 + I2 + I3 + I4 + I5 + I6;
            for (int it = gw_id; it < NITEMS; it += NGW) {
                int r = it;
                if (r < I0) { const int mat = r / (16 * 48), item = r % (16 * 48); transpose_item(ap->conv_w_in + (size_t)mat * 1024 * 3072, 1024, 3072, WCIN + (size_t)mat * 3072 * 1024, 1, scr, item, lane); continue; } r -= I0;
                if (r < I1) { const int mat = r / 256, item = r % 256; transpose_item(ap->conv_w_out + (size_t)mat * 1048576, 1024, 1024, WCOUT + (size_t)mat * 1048576, 0, scr, item, lane); continue; } r -= I1;
                if (r < I2) { const int mat = r / (16 * 144), item = r % (16 * 144); transpose_item(ap->attn_w_qkv + (size_t)mat * 1024 * 9216, 1024, 9216, WQKV + (size_t)mat * 9216 * 1024, 2, scr, item, lane); continue; } r -= I2;
                if (r < I3) { const int mat = r / 256, item = r % 256; transpose_item(ap->attn_w_o + (size_t)mat * 1048576, 1024, 1024, WO + (size_t)mat * 1048576, 0, scr, item, lane); continue; } r -= I3;
                if (r < I4) { const int mat = r / 128, item = r % 128; transpose_item(ap->w_gate + (size_t)mat * 524288, 1024, 512, WGU + (size_t)mat * 1048576, 3, scr, item, lane, ap->norm_ffn + (mat >> 4) * DM); continue; } r -= I4;
                if (r < I5) { const int mat = r / 128, item = r % 128; transpose_item(ap->w_up + (size_t)mat * 524288, 1024, 512, WGU + (size_t)mat * 1048576, 4, scr, item, lane, ap->norm_ffn + (mat >> 4) * DM); continue; } r -= I5;
                { const int mat = r / 128, item = r % 128; transpose_item(ap->w_down + (size_t)mat * 524288, 512, 1024, WDN + (size_t)mat * 524288, 0, scr, item, lane); }
            }
            for (int en = gw_id * 64 + lane; en < 4 * 8192; en += NGW * 64) router_image_entry(ap->w_coarse, ap->w_fine, ap->norm_ffn, ws + WS_RIMG, en);
            norm_rows<0>(ap->x, nullptr, nullptr, nullptr, ap->norm_mix, HN, gw_id, lane, false);
        } break;
        case T_CIN: if (PH_ON(T_CIN)) { TID_NOW(tid);
            pg8::Gemm g{HN, WCIN + (size_t)j2 * 3072 * 1024, 1024}; pg8::DenseOrder S; S.init(NTOK, 3072, G, bx);
            pg8::EpiConvIn E{(bf16_t*)(R + R_BG), (bf16_t*)(R + R_U)};
            pg8::gemm_phase<pg8::EpiConvIn, pg8::DenseOrder, false, true>(lds, g, S, E, tid);
        } break;
        case T_CONV: if (PH_ON(T_CONV)) { TID_NOW(tid);
            conv_phase((const bf16_t*)(R + R_BG), (const bf16_t*)(R + R_U), (bf16_t*)(R + R_Y), ap->conv_w + (size_t)j2 * 3072, gw_id, lane);
        } break;
        case T_COUT: case T_WO: if (PH_ON(T_COUT)) { TID_NOW(tid);
            const bf16_t* A = (type == T_COUT) ? (const bf16_t*)(R + R_Y) : HN;
            const bf16_t* Bt = (type == T_COUT) ? WCOUT + (size_t)j2 * 1048576 : WO + (size_t)j2 * 1048576;
            pg8::Gemm g{A, Bt, 1024}; pg8::DenseOrder S; S.init(NTOK, 1024, G, bx);
            pg8::EpiResB E{(L == 0) ? ap->x : nullptr, (const bf16_t*)ap->out, (L == DEPTH - 1) ? (bf16_t*)(R + R_H3) : (bf16_t*)ap->out};
            pg8::gemm_phase<pg8::EpiResB, pg8::DenseOrder, false, true>(lds, g, S, E, tid);
            if (MK_N_LAUNCHES == 1 && DUP_TYPE == -1) { TID_NOW(tidr); (void)tidr; router_image_to_lds(lds, ws + WS_RIMG + (size_t)L * 131072, wave, lane); }
        } break;
        case T_QKV: if (PH_ON(T_QKV)) { TID_NOW(tid);
            pg8::Gemm g{HN + (size_t)half * HTOK * DM, WQKV + (size_t)j2 * 9216 * 1024, 1024}; pg8::DenseOrder S; S.init(HTOK, QKVW, G, bx);
            pg8::EpiQKV E{(bf16_t*)R, ap->pos, half * HTOK};
            pg8::gemm_phase<pg8::EpiQKV, pg8::DenseOrder, false, true>(lds, g, S, E, tid);
        } break;
        case T_ATT: if (PH_ON(T_ATT)) { TID_NOW(tid);
            attn_phase_a(lds, (bf16_t*)R, (float*)(ws + WS_LSE), vcu, G, wave, lane, tid, dummy);
        } break;
        case T_ATTB: if (PH_ON(T_ATT)) { TID_NOW(tid);
            attn_phase_b(lds, (bf16_t*)R, (const float*)(ws + WS_LSE), HN + (size_t)half * HTOK * DM, vcu, G, wave, lane, tid, dummy);
        } break;
        case T_ROUTE: if (PH_ON(T_ROUTE)) { TID_NOW(tid);
            route_phase_mfma(lds, (L == DEPTH - 1) ? (const bf16_t*)(R + R_H3) : (const bf16_t*)ap->out, ws + WS_RIMG + (size_t)L * 131072, ap->b_coarse + L * 4, ap->b_fine + L * 16,
                             (unsigned*)(ctl + CW_CNT + 64 * L), list, gate, (float*)(ws + WS_RSC), gw_id, wave, lane, tid, dummy, MK_N_LAUNCHES == 1 && DUP_TYPE == -1);
        } break;
        case T_MOE1: case T_MOE2: if (PH_ON(T_MOE1)) { TID_NOW(tid);
            if (type == T_MOE1 || MK_N_LAUNCHES != 1) {
                if (wave == 0) {
                    if (tid == 0) { int uf = 0, ut = 0, hr = 0;
                        for (int e = 0; e < 16; ++e) { const int c = (int)__hip_atomic_load(ctl + CW_CNT + 64 * L + e, RLX_AGENT); const int full = c >> 8, tail = (c & 255) ? 1 : 0;
                            mtbl[e] = uf; mtbl[20 + e] = ut; mtbl[40 + e] = hr; mtbl[60 + e] = c; uf += full * 4; ut += tail * 4; hr += (full + tail) * 256; }
                        mtbl[16] = uf; mtbl[36] = ut; }
                    asm volatile("s_waitcnt lgkmcnt(0)" ::: "memory");
                    const int ta = mtbl[lane], tcn = mtbl[60 + (lane & 15)];
                    const int nfull = __builtin_amdgcn_readlane(ta, 16), total = nfull + __builtin_amdgcn_readlane(ta, 36);
                    for (int i = 0; i < pg8::MoeOrder::MAXU; ++i) {
                        int d = -1; const long Lq = (long)i * G + bx;
                        if (Lq < total) { int e, mt, pn;
                            if (Lq < nfull) {
                                int wgid = (int)Lq; { const int q = nfull / pg8::NXCD, r = nfull % pg8::NXCD, xcd = wgid % pg8::NXCD, off = wgid / pg8::NXCD; wgid = (xcd < r ? xcd * (q + 1) : r * (q + 1) + (xcd - r) * q) + off; }
                                e = __builtin_popcountll(__builtin_amdgcn_ballot_w64(lane >= 1 && lane < 16 && wgid >= ta));
                                const int Le = wgid - __builtin_amdgcn_readlane(ta, e); mt = Le >> 2; pn = Le & 3;
                            } else {
                                const int Lt = (int)Lq - nfull;
                                e = __builtin_popcountll(__builtin_amdgcn_ballot_w64(lane >= 21 && lane < 36 && Lt >= ta));
                                pn = Lt - __builtin_amdgcn_readlane(ta, 20 + e); mt = __builtin_amdgcn_readlane(tcn, e) >> 8;
                            }
                            d = e | (pn << 4) | (mt << 6); }
                        if (lane == 0) mtbl[80 + i] = d;
                    }
                }
                __syncthreads();
            }
            pg8::MoeOrder S{mtbl, G, bx, list};
            if (type == T_MOE1) {
                pg8::Gemm g{(L == DEPTH - 1) ? (const bf16_t*)(R + R_H3) : (const bf16_t*)ap->out, WGU + (size_t)L * 16 * 1048576, 1024};
                pg8::EpiMoeGU E{(bf16_t*)(R + R_H), (const float*)(ws + WS_RSC)};
                pg8::gemm_phase<pg8::EpiMoeGU, pg8::MoeOrder, true, true>(lds, g, S, E, tid);
            } else {
                pg8::Gemm g{(const bf16_t*)(R + R_H), WDN + (size_t)L * 16 * 524288, 512};
                pg8::EpiMoeDown E{(bf16_t*)(R + R_YS), list, gate};
                pg8::gemm_phase<pg8::EpiMoeDown, pg8::MoeOrder, false, true>(lds, g, S, E, tid);
            }
        } break;
        case T_NORM: if (PH_ON(T_NORM)) { TID_NOW(tid);
            if (L == DEPTH - 1) norm_rows<2>(nullptr, (bf16_t*)(R + R_H3), ap->out, (const bf16_t*)(R + R_YS), ap->norm_final, HN, gw_id, lane, dummy);
            else norm_rows<1>(nullptr, (bf16_t*)ap->out, ap->out, (const bf16_t*)(R + R_YS), ap->norm_mix + (L + 1) * DM, HN, gw_id, lane, dummy);
        } break;
        }
        unsigned tid2_z = 0u; asm volatile("" : "+v"(tid2_z)); const int tid2 = wave0 * 64 + (int)__builtin_amdgcn_mbcnt_hi(~0u, __builtin_amdgcn_mbcnt_lo(~0u, tid2_z));
#if PROBE
        if (bx == 0 && tid2 == 0) MISC[64 + ph] = (unsigned)(__builtin_amdgcn_s_memrealtime() - t_start);
        xcd_barrier(bar, tid2);
        if (bx == 0 && tid2 == 0) MISC[128 + ph] = (unsigned)(__builtin_amdgcn_s_memrealtime() - t_start);
#else
        if (is_dup) { if (dupstate == 0) { dupstate = 1; --ph; } else dupstate = 0; }
        if (ph + 1 < ph_hi) xcd_barrier(bar, tid2);
#endif
    }
#if PROBE
    if (bx == 0 && threadIdx.x < 64) {
        float sv = 0.f, sw = 0.f;
        for (int ph = 0; ph < NPHASE; ++ph) { const unsigned prev = ph ? MISC[128 + ph - 1] : 0u; const float tot = (float)(MISC[128 + ph] - prev) * 0.01f, work = (float)(MISC[64 + ph] - prev) * 0.01f;
            if ((PROBE_VM >> ph) & 1ull) sv += tot; if ((PROBE_WM >> ph) & 1ull) sw += PROBE_W_WORK ? work : tot; }
        float* o = ap0->out;
        if (threadIdx.x == 0) o[0] = 100.f + sv * 0.5f;
        for (int i = threadIdx.x; i < 4096; i += 64) o[4096 + i] = sw * 0.05f;
    }
#endif
}

extern "C" void kernel_launch(void* const* d_in, const int* in_sizes, int n_in, void* d_out, int out_size, void* d_ws, size_t ws_size, hipStream_t stream) {
    static int grid = 0;
    if (grid == 0) {
        if (n_in != 17 || in_sizes[0] != NTOK * DM || out_size != NTOK * DM || ws_size < WS_END) { fprintf(stderr, "kernel_launch: unexpected shapes/workspace (n_in %d, in0 %d, out %d, ws %zu < %zu)\n", n_in, n_in > 0 ? in_sizes[0] : -1, out_size, ws_size, (size_t)WS_END); grid = -1; return; }
        int dev = 0, cus = 0;
        if (hipGetDevice(&dev) != hipSuccess || hipDeviceGetAttribute(&cus, hipDeviceAttributeMultiprocessorCount, dev) != hipSuccess) { grid = -1; return; }
        if (hipFuncSetAttribute((const void*)hybrid_fwd, hipFuncAttributeMaxDynamicSharedMemorySize, LDS_BYTES) != hipSuccess) { fprintf(stderr, "kernel_launch: hipFuncSetAttribute failed\n"); grid = -1; return; }
        (void)hipGetLastError();
        grid = cus;
        if (grid != 256) fprintf(stderr, "kernel_launch: %d CUs (built for 256)\n", grid);
        if (grid < 96) { fprintf(stderr, "kernel_launch: too few CUs for the MoE unit descriptor table\n"); grid = -1; return; }
    }
    if (grid < 0) return;
    (void)hipMemsetAsync((char*)d_ws + WS_CTL, 0, CTL_ZERO_BYTES, stream);
    Args a{};
    a.x = (const float*)d_in[0]; a.pos = (const int*)d_in[1]; a.norm_mix = (const float*)d_in[2]; a.norm_ffn = (const float*)d_in[3]; a.norm_final = (const float*)d_in[4];
    a.conv_w_in = (const float*)d_in[5]; a.conv_w = (const float*)d_in[6]; a.conv_w_out = (const float*)d_in[7]; a.attn_w_qkv = (const float*)d_in[8]; a.attn_w_o = (const float*)d_in[9];
    a.w_coarse = (const float*)d_in[10]; a.b_coarse = (const float*)d_in[11]; a.w_fine = (const float*)d_in[12]; a.b_fine = (const float*)d_in[13];
    a.w_gate = (const float*)d_in[14]; a.w_up = (const float*)d_in[15]; a.w_down = (const float*)d_in[16];
    a.out = (float*)d_out; a.ws = (unsigned char*)d_ws;
    if (MK_N_LAUNCHES == 1) { a.ph_lo = 0; a.ph_hi = NPHASE; hipLaunchKernelGGL(hybrid_fwd, dim3(grid), dim3(NWAVES * 64), LDS_BYTES, stream, a); }
    else { for (int p = 0; p < NPHASE; ++p) { a.ph_lo = p; a.ph_hi = p + 1; hipLaunchKernelGGL(hybrid_fwd, dim3(grid), dim3(NWAVES * 64), LDS_BYTES, stream, a); } }
}
```
